# Optimizing an MI355X kernel written in HIP

```python
import jax, jax.numpy as jnp
from jax import lax
import numpy as np

D_MODEL = 1024
BATCH = 8
SEQ = 4096
DEPTH = 4

GRID_W = 64
CTX_LEN = 256
N_MIXERS = 2
N_CONV_LAYERS = (DEPTH + N_MIXERS - 1) // N_MIXERS
N_ATTN_LAYERS = DEPTH // N_MIXERS
HEAD_DIM = 128
N_HEADS = D_MODEL // HEAD_DIM
N_KV_HEADS = N_HEADS // 4
GQA_GROUP = N_HEADS // N_KV_HEADS
QKV_DIM = (N_HEADS + 2 * N_KV_HEADS) * HEAD_DIM
ROPE_THETA = 10000.0
ROPE_FREQS = HEAD_DIM // 4
Q_BLOCK = 128
D_FF = 2816
CONV_WIDTH = 3
N_SUBLAYERS = 3
N_MOD = 3
NORM_EPS = 1e-6
MACARON_WEIGHT = 0.5

kernel_name = "hybrid_conv_gqa_macaron_dit"


def rms_norm(x, g):
    xf = x.astype(jnp.float32)
    y = xf * lax.rsqrt(jnp.mean(xf * xf, axis=-1, keepdims=True) + NORM_EPS)
    return (y * g.astype(jnp.float32)).astype(x.dtype)


def norm_modulate(x, g, shift, scale):
    return rms_norm(x, g) * (1 + scale) + shift


def swiglu(h, w_in, w_out):
    gate, up = jnp.split(h @ w_in, 2, axis=-1)
    return (jax.nn.silu(gate) * up) @ w_out


def short_conv_mixer(h, w_in, w_conv, w_out):
    b_gate, c_gate, v = jnp.split(h @ w_in, 3, axis=-1)
    u = c_gate * v
    n = u.shape[1]
    half = CONV_WIDTH // 2
    u_pad = jnp.pad(u, ((0, 0), (half, half), (0, 0)))
    y = w_conv[0] * u_pad[:, 0:n]
    for k in range(1, CONV_WIDTH):
        y = y + w_conv[k] * u_pad[:, k:k + n]
    return (b_gate * y) @ w_out


def grid_rope_tables(n, dtype):
    rows_count = n // GRID_W
    row = jnp.broadcast_to(jnp.arange(rows_count, dtype=jnp.int32)[:, None], (rows_count, GRID_W)).reshape(-1)
    col = jnp.broadcast_to(jnp.arange(GRID_W, dtype=jnp.int32)[None, :], (rows_count, GRID_W)).reshape(-1)
    inv_freq = ROPE_THETA ** (-jnp.arange(ROPE_FREQS, dtype=jnp.float32) / ROPE_FREQS)
    ang = jnp.stack([row.astype(jnp.float32)[:, None] * inv_freq,
                     col.astype(jnp.float32)[:, None] * inv_freq], axis=1)
    ang = ang[:, None]
    return jnp.cos(ang).astype(dtype), jnp.sin(ang).astype(dtype)


def apply_rope_2d(x, cos, sin):
    b, n, h, d = x.shape
    xr = x.reshape(b, n, h, 2, 2, ROPE_FREQS)
    x1, x2 = xr[..., 0, :], xr[..., 1, :]
    out = jnp.stack([x1 * cos - x2 * sin, x2 * cos + x1 * sin], axis=-2)
    return out.reshape(b, n, h, d)


def project_qkv(h, w_qkv, q_g, k_g):
    b, n, _ = h.shape
    qkv = h @ w_qkv
    q = qkv[..., :N_HEADS * HEAD_DIM].reshape(b, n, N_HEADS, HEAD_DIM)
    k = qkv[..., N_HEADS * HEAD_DIM:(N_HEADS + N_KV_HEADS) * HEAD_DIM].reshape(b, n, N_KV_HEADS, HEAD_DIM)
    v = qkv[..., (N_HEADS + N_KV_HEADS) * HEAD_DIM:].reshape(b, n, N_KV_HEADS, HEAD_DIM)
    return rms_norm(q, q_g), rms_norm(k, k_g), v


def gqa_block(q, k, v):
    s = jnp.einsum('bqkgd,bskd->bkgqs', q, k).astype(jnp.float32) * (HEAD_DIM ** -0.5)
    p = jax.nn.softmax(s, axis=-1).astype(v.dtype)
    return jnp.einsum('bkgqs,bskd->bqkgd', p, v)


def attention_mixer(h_lat, h_ctx, w_qkv, q_g, k_g, w_o, cos, sin, need_ctx_out):
    b, n, _ = h_lat.shape
    q_l, k_l, v_l = project_qkv(h_lat, w_qkv, q_g, k_g)
    q_c, k_c, v_c = project_qkv(h_ctx, w_qkv, q_g, k_g)
    q_l = apply_rope_2d(q_l, cos, sin)
    k_l = apply_rope_2d(k_l, cos, sin)
    k_all = jnp.concatenate([k_c, k_l], axis=1)
    v_all = jnp.concatenate([v_c, v_l], axis=1)
    n_blocks = n // Q_BLOCK
    qb = q_l.reshape(b, n_blocks, Q_BLOCK, N_KV_HEADS, GQA_GROUP, HEAD_DIM).transpose(1, 0, 2, 3, 4, 5)
    o_l = lax.map(lambda q_blk: gqa_block(q_blk, k_all, v_all), qb)
    o_l = o_l.transpose(1, 0, 2, 3, 4, 5).reshape(b, n, N_HEADS * HEAD_DIM)
    y_lat = o_l @ w_o
    y_ctx = None
    if need_ctx_out:
        o_c = gqa_block(q_c.reshape(b, q_c.shape[1], N_KV_HEADS, GQA_GROUP, HEAD_DIM), k_c, v_c)
        y_ctx = o_c.reshape(b, q_c.shape[1], N_HEADS * HEAD_DIM) @ w_o
    return y_lat, y_ctx


def setup_inputs(seed: int = 0) -> dict:
    key = jax.random.key(seed)
    ks = jax.random.split(key, 20)
    d, f = D_MODEL, D_FF
    nrm = jax.random.normal
    return {
        "x": nrm(ks[0], (BATCH, SEQ, d), jnp.float32),
        "c": nrm(ks[1], (BATCH, d), jnp.float32),
        "ctx": nrm(ks[2], (BATCH, CTX_LEN, d), jnp.float32),
        "c_ctx": nrm(ks[3], (d,), jnp.float32),
        "ada_w": nrm(ks[4], (DEPTH, d, N_SUBLAYERS * N_MOD * d), jnp.float32) * (0.5 * d ** -0.5),
        "ada_b": nrm(ks[5], (DEPTH, N_SUBLAYERS * N_MOD * d), jnp.float32) * 0.02,
        "norm_g": 1.0 + 0.02 * nrm(ks[6], (DEPTH, N_SUBLAYERS, d), jnp.float32),
        "final_g": 1.0 + 0.02 * nrm(ks[7], (d,), jnp.float32),
        "ffn_w_in": nrm(ks[8], (DEPTH, 2, d, 2 * f), jnp.float32) * d ** -0.5,
        "ffn_w_out": nrm(ks[9], (DEPTH, 2, f, d), jnp.float32) * f ** -0.5,
        "conv_w_in": nrm(ks[10], (N_CONV_LAYERS, d, 3 * d), jnp.float32) * d ** -0.5,
        "conv_w": nrm(ks[11], (N_CONV_LAYERS, CONV_WIDTH, d), jnp.float32) * CONV_WIDTH ** -0.5,
        "conv_w_out": nrm(ks[12], (N_CONV_LAYERS, d, d), jnp.float32) * d ** -0.5,
        "attn_w_qkv": nrm(ks[13], (N_ATTN_LAYERS, d, QKV_DIM), jnp.float32) * d ** -0.5,
        "attn_q_g": 1.0 + 0.02 * nrm(ks[14], (N_ATTN_LAYERS, HEAD_DIM), jnp.float32),
        "attn_k_g": 1.0 + 0.02 * nrm(ks[15], (N_ATTN_LAYERS, HEAD_DIM), jnp.float32),
        "attn_w_o": nrm(ks[16], (N_ATTN_LAYERS, N_HEADS * HEAD_DIM, d), jnp.float32) * (N_HEADS * HEAD_DIM) ** -0.5,
    }


def reference(x, c, ctx, c_ctx, ada_w, ada_b, norm_g, final_g, ffn_w_in, ffn_w_out,
              conv_w_in, conv_w, conv_w_out, attn_w_qkv, attn_q_g, attn_k_g, attn_w_o):
    b, n, d = x.shape
    cos, sin = grid_rope_tables(n, x.dtype)
    silu_c = jax.nn.silu(c)
    silu_cc = jax.nn.silu(c_ctx)
    x_lat, x_ctx = x, ctx
    for i in range(DEPTH):
        is_attn = (i % N_MIXERS) == 1
        last = i == DEPTH - 1
        ctx_feeds_mixer = (not last) or is_attn
        m_lat = (silu_c @ ada_w[i] + ada_b[i]).reshape(b, N_SUBLAYERS, N_MOD, 1, d)
        m_ctx = (silu_cc @ ada_w[i] + ada_b[i]).reshape(N_SUBLAYERS, N_MOD, 1, d)
        h = norm_modulate(x_lat, norm_g[i, 0], m_lat[:, 0, 0], m_lat[:, 0, 1])
        x_lat = x_lat + MACARON_WEIGHT * m_lat[:, 0, 2] * swiglu(h, ffn_w_in[i, 0], ffn_w_out[i, 0])
        if ctx_feeds_mixer:
            hc = norm_modulate(x_ctx, norm_g[i, 0], m_ctx[0, 0], m_ctx[0, 1])
            x_ctx = x_ctx + MACARON_WEIGHT * m_ctx[0, 2] * swiglu(hc, ffn_w_in[i, 0], ffn_w_out[i, 0])
        h = norm_modulate(x_lat, norm_g[i, 1], m_lat[:, 1, 0], m_lat[:, 1, 1])
        if is_attn:
            j = i // N_MIXERS
            hc = norm_modulate(x_ctx, norm_g[i, 1], m_ctx[1, 0], m_ctx[1, 1])
            y_lat, y_ctx = attention_mixer(h, hc, attn_w_qkv[j], attn_q_g[j], attn_k_g[j], attn_w_o[j],
                                           cos, sin, not last)
        else:
            j = i // N_MIXERS
            y_lat = short_conv_mixer(h, conv_w_in[j], conv_w[j], conv_w_out[j])
            y_ctx = None
            if not last:
                hc = norm_modulate(x_ctx, norm_g[i, 1], m_ctx[1, 0], m_ctx[1, 1])
                y_ctx = short_conv_mixer(hc, conv_w_in[j], conv_w[j], conv_w_out[j])
        x_lat = x_lat + m_lat[:, 1, 2] * y_lat
        if not last:
            x_ctx = x_ctx + m_ctx[1, 2] * y_ctx
        h = norm_modulate(x_lat, norm_g[i, 2], m_lat[:, 2, 0], m_lat[:, 2, 1])
        x_lat = x_lat + MACARON_WEIGHT * m_lat[:, 2, 2] * swiglu(h, ffn_w_in[i, 1], ffn_w_out[i, 1])
        if not last:
            hc = norm_modulate(x_ctx, norm_g[i, 2], m_ctx[2, 0], m_ctx[2, 1])
            x_ctx = x_ctx + MACARON_WEIGHT * m_ctx[2, 2] * swiglu(hc, ffn_w_in[i, 1], ffn_w_out[i, 1])
    return rms_norm(x_lat, final_g)
```

```cpp
#include <hip/hip_runtime.h>
#include <hip/hip_bf16.h>
#include <hip/hip_cooperative_groups.h>
#include <cstdio>
#include <cstdint>
#include <cstddef>
#include <cmath>
namespace cg = cooperative_groups;
__device__ __forceinline__ int opaque_tid() { int t = threadIdx.x; asm volatile("" : "+v"(t)); return t; }
namespace pg8 {
#define PG8_LAS __attribute__((address_space(3)))
typedef unsigned short bf16_t;
typedef short bf16x8 __attribute__((ext_vector_type(8)));
typedef float f32x4 __attribute__((ext_vector_type(4)));
typedef unsigned u32x4 __attribute__((ext_vector_type(4)));
typedef unsigned u32x2 __attribute__((ext_vector_type(2)));
constexpr int BM = 256, BK = 64, HALF = 128, HTB = HALF * BK * 2  , STAGE_BYTES = 8 * HTB, NXCD = 8, WGM = 8;

__host__ __device__ __forceinline__ int lds_byte(int r, int c) { const int st = (r >> 4) * 2 + (c >> 5), rr = r & 15, cc = c & 31, ob = rr * 64 + cc * 2; return st * 1024 + (ob ^ (((ob >> 9) & 1) << 5)); }
__host__ __device__ __forceinline__ void stage_rc(int b, int& R, int& C) { const int st = b / 1024, sb = b % 1024, swz = sb ^ (((sb >> 9) & 1) << 5); R = (st >> 1) * 16 + swz / 64; C = (st & 1) * 32 + (swz % 64) / 2; }
__host__ __device__ __forceinline__ int perm32(int rho) { const int n = rho >> 4, i = rho & 15; return 8 * (i >> 2) + 4 * n + (i & 3); }

struct Unit { int pm, pn, kt0, nkt, sliced, ha, hb; };
struct Gemm { const bf16_t* A; const bf16_t* Bt; int M, N, K; };

struct StaticOrder {
    int nM, nN, nwg, G, c, nkt, lat;
    __host__ __device__ void init(int M, int N, int K, int G_, int c_, int lat_ = 0) { lat = lat_; nM = lat ? 128 : M / BM; nN = N / BM; nwg = nM * nN; G = G_; c = c_; nkt = K / BK; }
    __host__ __device__ bool next(int i, Unit& u) const {
        const long L = (long)i * G + c; if (L >= nwg) return false;
        u.kt0 = 0; u.nkt = nkt; u.sliced = 0; u.ha = -1; u.hb = -1;
        int wgid = (int)L; { const int q = nwg / NXCD, r = nwg % NXCD, xcd = wgid % NXCD, off = wgid / NXCD; wgid = (xcd < r ? xcd * (q + 1) : r * (q + 1) + (xcd - r) * q) + off; }
        const int nig = WGM * nN, gid = wgid / nig, fm = gid * WGM, gsz = (nM - fm) < WGM ? (nM - fm) : WGM;
        u.pm = fm + ((wgid % nig) % gsz); u.pn = (wgid % nig) / gsz; if (lat) u.pm += (u.pm >> 4) + 1; return true;
    }
    __device__ __forceinline__ void a_ready(const Unit&) const {}
    __device__ __forceinline__ void done(const Unit&) const {}
};
struct TailOrder {
    int nM, nN, nwg, G, c, nkt, rounds, left, mode, lat;
    __host__ __device__ void init(int M, int N, int K, int G_, int c_, int lat_ = 0) { lat = lat_; nM = lat ? 128 : M / BM; nN = N / BM; nwg = nM * nN; G = G_; c = c_; nkt = K / BK; rounds = nwg / G; left = nwg - rounds * G; mode = 0;
        if (left > 0) { if (left * 4 <= G) mode = 4; else if (left * 2 <= G) mode = 2; } }
    __host__ __device__ void tile(int wgid, Unit& u) const {
        { const int q = nwg / NXCD, r = nwg % NXCD, xcd = wgid % NXCD, off = wgid / NXCD; wgid = (xcd < r ? xcd * (q + 1) : r * (q + 1) + (xcd - r) * q) + off; }
        const int nig = WGM * nN, gid = wgid / nig, fm = gid * WGM, gsz = (nM - fm) < WGM ? (nM - fm) : WGM;
        u.pm = fm + ((wgid % nig) % gsz); u.pn = (wgid % nig) / gsz; if (lat) u.pm += (u.pm >> 4) + 1; }
    __host__ __device__ bool next(int i, Unit& u) const {
        u.kt0 = 0; u.nkt = nkt; u.sliced = 0; u.ha = -1; u.hb = -1;
        if (mode == 0 || i < rounds) { const long L = (long)i * G + c; if (L >= nwg) return false; tile((int)L, u); return true; }
        if (i > rounds || c >= left * mode) return false;
        int t, piece;
        if ((left & 7) == 0) { const int q = c >> 3, x = c & 7; t = x + 8 * (q / mode); piece = q % mode; } else { t = c / mode; piece = c % mode; }
        tile(rounds * G + t, u); u.ha = piece & 1; u.hb = (mode == 4) ? (piece >> 1) : -1; return true;
    }
    __device__ __forceinline__ void a_ready(const Unit&) const {}
    __device__ __forceinline__ void done(const Unit&) const {}
};
struct SlicedOrder {
    int nM, nN, nwg, G, c, nkt, rounds, left, ns;
    __host__ __device__ void init(int M, int N, int K, int G_, int c_) { nM = M / BM; nN = N / BM; nwg = nM * nN; G = G_; c = c_; nkt = K / BK; rounds = nwg / G; left = nwg - rounds * G; ns = 0;
        if (left > 0 && G % left == 0 && (nkt / 2) >= G / left) ns = G / left; }
    __host__ __device__ void tile(int wgid, Unit& u) const {
        { const int q = nwg / NXCD, r = nwg % NXCD, xcd = wgid % NXCD, off = wgid / NXCD; wgid = (xcd < r ? xcd * (q + 1) : r * (q + 1) + (xcd - r) * q) + off; }
        const int nig = WGM * nN, gid = wgid / nig, fm = gid * WGM, gsz = (nM - fm) < WGM ? (nM - fm) : WGM;
        u.pm = fm + ((wgid % nig) % gsz); u.pn = (wgid % nig) / gsz; }
    __host__ __device__ bool next(int i, Unit& u) const {
        if (ns == 0 || i < rounds) { const long L = (long)i * G + c; if (L >= nwg) return false; tile((int)L, u); u.kt0 = 0; u.nkt = nkt; u.sliced = 0; u.ha = -1; u.hb = -1; return true; }
        if (i > rounds) return false;
        const int sl = c / left, pairs = nkt / 2, base = pairs / ns, rem = pairs % ns;
        tile(rounds * G + c % left, u); u.kt0 = 2 * (sl * base + (sl < rem ? sl : rem)); u.nkt = 2 * (base + (sl < rem ? 1 : 0)); u.sliced = 1; u.ha = -1; u.hb = -1; return true;
    }
    __device__ __forceinline__ void a_ready(const Unit&) const {}
    __device__ __forceinline__ void done(const Unit&) const {}
};

__device__ __forceinline__ unsigned cvt_pk_bf16(float lo, float hi) { unsigned r; asm volatile("v_cvt_pk_bf16_f32 %0, %1, %2" : "=v"(r) : "v"(lo), "v"(hi)); return r; }
typedef float f32x2 __attribute__((ext_vector_type(2)));
__device__ __forceinline__ f32x2 gelu_pk(f32x2 v) {
    const f32x2 av = __builtin_elementwise_abs(v), d = av * 0.2316418882f + 1.0f;
    f32x2 t; t.x = __builtin_amdgcn_rcpf(d.x); t.y = __builtin_amdgcn_rcpf(d.y);
    f32x2 q = t * 0.5307027145f + (-0.7265760135f); q = q * t + 0.7107068705f; q = q * t + (-0.142248368f); q = q * t + 0.127414796f; q = q * t;
    const f32x2 s = (v * v) * (-0.72134752044f);
    f32x2 e; e.x = __builtin_amdgcn_exp2f(s.x); e.y = __builtin_amdgcn_exp2f(s.y);
    const f32x2 m = v * (q * e), r = v - m;
    f32x2 o; o.x = v.x < 0.f ? m.x : r.x; o.y = v.y < 0.f ? m.y : r.y; return o;
}

template <int ACT  > struct EpiBf16 {
    static constexpr bool PERM = true, AFTER_DRAIN = false; static_assert(ACT == 0 || ACT == 1, "EpiBf16: ACT is 0 (none) or 1 (gelu_pk)");
    bf16_t* O; int ldc; const float* bias; int split_cols; size_t split_stride; float scale0;
    __device__ __forceinline__ void operator()(const f32x4 (&acc)[2][2][4][2], const Unit& u, int wr, int wc, int fr, int fq) const {
        const int row0 = u.pm * BM + wr * 64 + fr; int colt = u.pn * BM; bf16_t* base = O;
        float sc = 1.f; if (split_cols) { const int t = colt / split_cols; base += (size_t)t * split_stride; colt -= t * split_cols; if (t == 0) sc = scale0; }
        const int col0 = colt + wc * 32 + 8 * fq, bcol0 = u.pn * BM + wc * 32 + 8 * fq;
        f32x4 bv[2][2];
#pragma unroll
        for (int bj = 0; bj < 2; ++bj)
#pragma unroll
            for (int n = 0; n < 2; ++n) bv[bj][n] = bias ? *(const f32x4*)(bias + bcol0 + bj * HALF + 4 * n) : (f32x4){0.f, 0.f, 0.f, 0.f};
#pragma unroll
        for (int ai = 0; ai < 2; ++ai)
#pragma unroll
            for (int m = 0; m < 4; ++m) { bf16_t* rowp = base + (size_t)(row0 + ai * HALF + m * 16) * ldc + col0;
#pragma unroll
                for (int bj = 0; bj < 2; ++bj) { f32x4 v0 = acc[ai][bj][m][0] + bv[bj][0], v1 = acc[ai][bj][m][1] + bv[bj][1];
                    if (ACT == 1) { f32x2 a = gelu_pk((f32x2){v0[0], v0[1]}), b = gelu_pk((f32x2){v0[2], v0[3]}), c = gelu_pk((f32x2){v1[0], v1[1]}), d = gelu_pk((f32x2){v1[2], v1[3]});
                        v0 = (f32x4){a.x, a.y, b.x, b.y}; v1 = (f32x4){c.x, c.y, d.x, d.y}; }
                    v0 = v0 * sc; v1 = v1 * sc; u32x4 w; w.x = cvt_pk_bf16(v0[0], v0[1]); w.y = cvt_pk_bf16(v0[2], v0[3]); w.z = cvt_pk_bf16(v1[0], v1[1]); w.w = cvt_pk_bf16(v1[2], v1[3]);
                    *(u32x4*)(rowp + bj * HALF) = w; } }
    }
};
__device__ __forceinline__ int mod_index(int pm) { const int b = pm / 17; return (pm - b * 17 == 0) ? 8 : b; }
__device__ __forceinline__ f32x2 swiglu_pk(f32x2 g, f32x2 u) {
    const f32x2 t = g * (-1.4426950408889634f); f32x2 e; e.x = __builtin_amdgcn_exp2f(t.x); e.y = __builtin_amdgcn_exp2f(t.y);
    const f32x2 d = e + 1.0f; f32x2 r; r.x = __builtin_amdgcn_rcpf(d.x); r.y = __builtin_amdgcn_rcpf(d.y);
    return (g * u) * r; }
__device__ __forceinline__ float silu_f(float g) { return g * __builtin_amdgcn_rcpf(1.0f + __builtin_amdgcn_exp2f(-1.4426950408889634f * g)); }
__device__ __forceinline__ float rstd_of(const float* rss, int row) { return 1.0f / sqrtf(rss[row] * (1.0f / 1024.0f) + 1e-6f); }
struct EpiSwiglu {
    static constexpr bool PERM = true, AFTER_DRAIN = false;
    bf16_t* O; int ldc; const float* rss; const float* sw;
    struct Pf { float r[2][4]; f32x4 bg0, bg1, bu0, bu1; };
    __device__ __forceinline__ Pf prefetch(const Unit& u, int wr, int fr) const { Pf p; const int row0 = u.pm * BM + wr * 64 + fr;
        const int lane = threadIdx.x & 63, wc = (threadIdx.x >> 6) & 3, fq = lane >> 4;
#pragma unroll
        for (int ai = 0; ai < 2; ++ai)
#pragma unroll
            for (int m = 0; m < 4; ++m) p.r[ai][m] = rss[row0 + ai * HALF + m * 16];
        const float* bp = sw + (size_t)mod_index(u.pm) * 5632 + u.pn * BM + wc * 32 + 8 * fq;
        p.bg0 = *(const f32x4*)bp; p.bg1 = *(const f32x4*)(bp + 4); p.bu0 = *(const f32x4*)(bp + HALF); p.bu1 = *(const f32x4*)(bp + HALF + 4);
        return p; }
    __device__ __forceinline__ void operator()(const f32x4 (&acc)[2][2][4][2], const Unit& u, int wr, int wc, int fr, int fq, const Pf& pf) const {
        const int row0 = u.pm * BM + wr * 64 + fr, col0 = u.pn * HALF + wc * 32 + 8 * fq;
        const f32x4 bg0 = pf.bg0, bg1 = pf.bg1, bu0 = pf.bu0, bu1 = pf.bu1;
#pragma unroll
        for (int ai = 0; ai < 2; ++ai)
#pragma unroll
            for (int m = 0; m < 4; ++m) { const int row = row0 + ai * HALF + m * 16; bf16_t* rowp = O + (size_t)row * ldc + col0; const float rs = __builtin_amdgcn_rsqf(pf.r[ai][m] * (1.0f / 1024.0f) + 1e-6f);
                const f32x4 g0 = acc[ai][0][m][0] * rs + bg0, g1 = acc[ai][0][m][1] * rs + bg1, u0 = acc[ai][1][m][0] * rs + bu0, u1 = acc[ai][1][m][1] * rs + bu1;
                const f32x2 ha = swiglu_pk((f32x2){g0[0], g0[1]}, (f32x2){u0[0], u0[1]}), hb = swiglu_pk((f32x2){g0[2], g0[3]}, (f32x2){u0[2], u0[3]});
                const f32x2 hc = swiglu_pk((f32x2){g1[0], g1[1]}, (f32x2){u1[0], u1[1]}), hd = swiglu_pk((f32x2){g1[2], g1[3]}, (f32x2){u1[2], u1[3]});
                u32x4 w; w.x = cvt_pk_bf16(ha.x, ha.y); w.y = cvt_pk_bf16(hb.x, hb.y); w.z = cvt_pk_bf16(hc.x, hc.y); w.w = cvt_pk_bf16(hd.x, hd.y);
                *(u32x4*)rowp = w; }
    }
};
struct EpiBf16N {
    static constexpr bool PERM = true, AFTER_DRAIN = false;
    bf16_t* O; int ldc; const float* rss; const float* sw;
    struct Pf { float r[2][4]; };
    __device__ __forceinline__ Pf prefetch(const Unit& u, int wr, int fr) const { Pf p; const int row0 = u.pm * BM + (u.ha > 0 ? HALF : 0) + wr * 64 + fr;
#pragma unroll
        for (int ai = 0; ai < 2; ++ai)
#pragma unroll
            for (int m = 0; m < 4; ++m) p.r[ai][m] = rss[row0 + ai * HALF + m * 16];
        return p; }
    __device__ __forceinline__ void operator()(const f32x4 (&acc)[2][2][4][2], const Unit& u, int wr, int wc, int fr, int fq, const Pf& pf) const {
        const int row0 = u.pm * BM + (u.ha > 0 ? HALF : 0) + wr * 64 + fr, col0 = u.pn * BM + (u.hb > 0 ? HALF : 0) + wc * 32 + 8 * fq; const int na = u.ha < 0 ? 2 : 1, nb = u.hb < 0 ? 2 : 1;
        const float* bp = sw + (size_t)mod_index(u.pm) * 5632 + col0;
        f32x4 bv[2][2];
#pragma unroll
        for (int bj = 0; bj < 2; ++bj)
#pragma unroll
            for (int n = 0; n < 2; ++n) bv[bj][n] = *(const f32x4*)(bp + bj * HALF + 4 * n);
#pragma unroll
        for (int ai = 0; ai < 2; ++ai) if (ai < na)
#pragma unroll
            for (int m = 0; m < 4; ++m) { const int row = row0 + ai * HALF + m * 16; bf16_t* rowp = O + (size_t)row * ldc + col0; const float rs = __builtin_amdgcn_rsqf(pf.r[ai][m] * (1.0f / 1024.0f) + 1e-6f);
#pragma unroll
                for (int bj = 0; bj < 2; ++bj) if (bj < nb) { const f32x4 v0 = acc[ai][bj][m][0] * rs + bv[bj][0], v1 = acc[ai][bj][m][1] * rs + bv[bj][1];
                    u32x4 w; w.x = cvt_pk_bf16(v0[0], v0[1]); w.y = cvt_pk_bf16(v0[2], v0[3]); w.z = cvt_pk_bf16(v1[0], v1[1]); w.w = cvt_pk_bf16(v1[2], v1[3]);
                    *(u32x4*)(rowp + bj * HALF) = w; } }
    }
};
struct EpiConvIn {
    static constexpr bool PERM = true, AFTER_DRAIN = false;
    bf16_t* O; const float* rss; const float* sw;
    struct Pf { float r[2][4]; };
    __device__ __forceinline__ Pf prefetch(const Unit& u, int wr, int fr) const { Pf p; const int row0 = u.pm * BM + (u.ha > 0 ? HALF : 0) + wr * 64 + fr;
#pragma unroll
        for (int ai = 0; ai < 2; ++ai)
#pragma unroll
            for (int m = 0; m < 4; ++m) p.r[ai][m] = rss[row0 + ai * HALF + m * 16];
        return p; }
    __device__ __forceinline__ void operator()(const f32x4 (&acc)[2][2][4][2], const Unit& u, int wr, int wc, int fr, int fq, const Pf& pf) const {
        const int row0 = u.pm * BM + (u.ha > 0 ? HALF : 0) + wr * 64 + fr; const int na = u.ha < 0 ? 2 : 1;
        const float* bp = sw + (size_t)mod_index(u.pm) * 5632 + u.pn * BM + wc * 32 + 8 * fq;
        f32x4 bv[2][2];
#pragma unroll
        for (int bj = 0; bj < 2; ++bj)
#pragma unroll
            for (int n = 0; n < 2; ++n) bv[bj][n] = *(const f32x4*)(bp + bj * HALF + 4 * n);
        const bool paired = u.pn >= 4;
        const int col0 = paired ? 1024 + (u.pn - 4) * HALF + wc * 32 + 8 * fq : u.pn * BM + wc * 32 + 8 * fq;
#pragma unroll
        for (int ai = 0; ai < 2; ++ai) if (ai < na)
#pragma unroll
            for (int m = 0; m < 4; ++m) { const int row = row0 + ai * HALF + m * 16; bf16_t* rowp = O + (size_t)row * 2048 + col0; const float rs = __builtin_amdgcn_rsqf(pf.r[ai][m] * (1.0f / 1024.0f) + 1e-6f);
                const f32x4 a0 = acc[ai][0][m][0] * rs + bv[0][0], a1 = acc[ai][0][m][1] * rs + bv[0][1], c0 = acc[ai][1][m][0] * rs + bv[1][0], c1 = acc[ai][1][m][1] * rs + bv[1][1];
                if (paired) { const f32x4 p0 = a0 * c0, p1 = a1 * c1;
                    u32x4 w; w.x = cvt_pk_bf16(p0[0], p0[1]); w.y = cvt_pk_bf16(p0[2], p0[3]); w.z = cvt_pk_bf16(p1[0], p1[1]); w.w = cvt_pk_bf16(p1[2], p1[3]);
                    *(u32x4*)rowp = w; }
                else { u32x4 w; w.x = cvt_pk_bf16(a0[0], a0[1]); w.y = cvt_pk_bf16(a0[2], a0[3]); w.z = cvt_pk_bf16(a1[0], a1[1]); w.w = cvt_pk_bf16(a1[2], a1[3]);
                    *(u32x4*)rowp = w;
                    u32x4 w2; w2.x = cvt_pk_bf16(c0[0], c0[1]); w2.y = cvt_pk_bf16(c0[2], c0[3]); w2.z = cvt_pk_bf16(c1[0], c1[1]); w2.w = cvt_pk_bf16(c1[2], c1[3]);
                    *(u32x4*)(rowp + HALF) = w2; } }
    }
};
struct EpiRes {
    static constexpr bool PERM = true, AFTER_DRAIN = false;
    float* X; const float* gate; int halfstep; bf16_t* xs; const float* gn; const float* scn; float* rssn;
    struct Pf {};
    __device__ __forceinline__ Pf prefetch(const Unit&, int, int) const { return Pf{}; }
    template <int NA, int NB, bool FOLD>
    __device__ __forceinline__ void body(const f32x4 (&acc)[2][2][4][2], const Unit& u, int wr, int wc, int fr, int fq) const {
        const int mi = mod_index(u.pm); const float coef = halfstep ? 0.5f : 1.0f;
        const float* gv = gate + (size_t)mi * 36864;
        const int col0 = u.pn * BM + wc * 32 + 8 * fq + (u.hb > 0 ? HALF : 0); const int rofs = u.ha > 0 ? HALF : 0;
        f32x4 gg[NB][2], gs[NB][2];
#pragma unroll
        for (int bj = 0; bj < NB; ++bj)
#pragma unroll
            for (int n = 0; n < 2; ++n) { gg[bj][n] = *(const f32x4*)(gv + col0 + bj * HALF + n * 4) * coef;
                if (FOLD) gs[bj][n] = *(const f32x4*)(gn + col0 + bj * HALF + n * 4) * (*(const f32x4*)(scn + (size_t)mi * 36864 + col0 + bj * HALF + n * 4) + 1.0f); }
#pragma unroll
        for (int ai = 0; ai < NA; ++ai) {
#pragma unroll
          for (int mh = 0; mh < 2; ++mh) {
            f32x4 pre[2][NB][2];
#pragma unroll
            for (int mm = 0; mm < 2; ++mm) { const int m = mh * 2 + mm; const float* xp = X + (size_t)(u.pm * BM + rofs + ai * HALF + wr * 64 + m * 16 + fr) * 1024 + col0;
#pragma unroll
                for (int bj = 0; bj < NB; ++bj)
#pragma unroll
                    for (int n = 0; n < 2; ++n) pre[mm][bj][n] = __builtin_nontemporal_load((const f32x4*)(xp + bj * HALF + n * 4)); }
            asm volatile("" ::: "memory");
#pragma unroll
            for (int mm = 0; mm < 2; ++mm) { const int m = mh * 2 + mm; const int row = u.pm * BM + rofs + ai * HALF + wr * 64 + m * 16 + fr; float* xp = X + (size_t)row * 1024 + col0; float ss = 0.f;
#pragma unroll
                for (int bj = 0; bj < NB; ++bj) { float* p = xp + bj * HALF;
                    const f32x4 x0 = pre[mm][bj][0] + gg[bj][0] * acc[ai][bj][m][0], x1 = pre[mm][bj][1] + gg[bj][1] * acc[ai][bj][m][1];
                    __builtin_nontemporal_store(x0, (f32x4*)p); __builtin_nontemporal_store(x1, (f32x4*)(p + 4));
                    if (FOLD) { const f32x4 q = x0 * x0 + x1 * x1; ss += (q[0] + q[1]) + (q[2] + q[3]);
                        const f32x4 o0 = x0 * gs[bj][0], o1 = x1 * gs[bj][1];
                        u32x4 w; w.x = cvt_pk_bf16(o0[0], o0[1]); w.y = cvt_pk_bf16(o0[2], o0[3]); w.z = cvt_pk_bf16(o1[0], o1[1]); w.w = cvt_pk_bf16(o1[2], o1[3]);
                        *(u32x4*)(xs + (size_t)row * 1024 + col0 + bj * HALF) = w; } }
                if (FOLD) { ss += __shfl_xor(ss, 16); ss += __shfl_xor(ss, 32); if (fq == 0) unsafeAtomicAdd(rssn + row, ss); } }
            asm volatile("" ::: "memory"); } }
    }
    __device__ __forceinline__ void operator()(const f32x4 (&acc)[2][2][4][2], const Unit& u, int wr, int wc, int fr, int fq, const Pf&) const {
        const bool fold = xs != nullptr;
        if (u.ha < 0 && u.hb < 0) { if (fold) body<2, 2, true>(acc, u, wr, wc, fr, fq); else body<2, 2, false>(acc, u, wr, wc, fr, fq); }
        else if (u.hb < 0) { if (fold) body<1, 2, true>(acc, u, wr, wc, fr, fq); else body<1, 2, false>(acc, u, wr, wc, fr, fq); }
        else { if (fold) body<1, 1, true>(acc, u, wr, wc, fr, fq); else body<1, 1, false>(acc, u, wr, wc, fr, fq); }
    }
};

template <class Epi, class Sched, bool ALIGN_EPI = false, bool SP2 = false>
__device__ __forceinline__ void gemm_phase(PG8_LAS unsigned char* lds, const Gemm g, const Sched& S, const Epi& E) {
    const int tid = opaque_tid(), wid = __builtin_amdgcn_readfirstlane(tid >> 6), lane = tid & 63, wr = wid >> 2, wc = wid & 3, fr = lane & 15, fq = lane >> 4;
    const int K = g.K;
    unsigned voffA[2], voffB[2];
#pragma unroll
    for (int i = 0; i < 2; ++i) { int R, C; stage_rc(tid * 16 + i * 8192, R, C); const int Rb = Epi::PERM ? ((R & ~31) + perm32(R & 31)) : R;
        voffA[i] = (unsigned)(R * K + C) * 2u; voffB[i] = (unsigned)(Rb * K + C) * 2u; }
    const size_t kstep = (size_t)(BK * 2);
    const size_t hstep = (size_t)HALF * K * 2;
    const size_t tstep = 2 * hstep;
    const unsigned ldsw = (unsigned)wid * 1024u;
    const int aoff = lds_byte(wr * 64 + fr, fq * 8), boff = lds_byte(wc * 32 + fr, fq * 8);
#define PG8_SA(b, h) (((b) * 2 + (h)) * HTB)
#define PG8_SB(b, h) ((4 + (b) * 2 + (h)) * HTB)
#define PG8_STAGE(bufoff, gbase, voff) do { _Pragma("unroll") for (int _i = 0; _i < 2; ++_i) \
        __builtin_amdgcn_global_load_lds((const unsigned*)((const char*)(gbase) + (voff)[_i]), (PG8_LAS unsigned*)(lds + (bufoff) + ldsw + _i * 8192), 16, 0, 0); } while (0)
#define PG8_LDA(dst, b, h) do { _Pragma("unroll") for (int m = 0; m < 4; ++m) _Pragma("unroll") for (int k = 0; k < 2; ++k) dst[m][k] = *(const PG8_LAS bf16x8*)(lds + PG8_SA(b, h) + aoff + m * 2048 + k * 1024); } while (0)
#define PG8_LDB(dst, b, h) do { _Pragma("unroll") for (int n = 0; n < 2; ++n) _Pragma("unroll") for (int k = 0; k < 2; ++k) dst[n][k] = *(const PG8_LAS bf16x8*)(lds + PG8_SB(b, h) + boff + n * 2048 + k * 1024); } while (0)
#define PG8_MMA(ai, bj, At, Bt) do { __builtin_amdgcn_s_setprio(1); _Pragma("unroll") for (int m = 0; m < 4; ++m) _Pragma("unroll") for (int n = 0; n < 2; ++n) _Pragma("unroll") for (int k = 0; k < 2; ++k) \
        acc[ai][bj][m][n] = __builtin_amdgcn_mfma_f32_16x16x32_bf16(Bt[n][k], At[m][k], acc[ai][bj][m][n], 0, 0, 0); __builtin_amdgcn_s_setprio(0); } while (0)
#define PG8_WAIT_V(n) asm volatile("s_waitcnt vmcnt(" #n ")" ::: "memory")
#define PG8_WAIT_L(n) asm volatile("s_waitcnt lgkmcnt(" #n ")" ::: "memory")
#define PG8_BAR __builtin_amdgcn_s_barrier()
#define PG8_SCHED __builtin_amdgcn_sched_barrier(0)
    Unit cur, nxt; int ui = 0;
    if (!S.next(0, cur)) return;
    f32x4 acc[2][2][4][2];
#pragma unroll
    for (int a = 0; a < 2; ++a)
#pragma unroll
        for (int b = 0; b < 2; ++b)
#pragma unroll
            for (int m = 0; m < 4; ++m)
#pragma unroll
                for (int n = 0; n < 2; ++n) acc[a][b][m][n] = (f32x4){0.f, 0.f, 0.f, 0.f};
    bf16x8 At[4][2], B0[2][2], B1[2][2];
    const char* cA = (const char*)g.A + (size_t)cur.pm * tstep + (size_t)cur.kt0 * kstep + (cur.ha > 0 ? hstep : (size_t)0); const char* cB = (const char*)g.Bt + (size_t)cur.pn * tstep + (size_t)cur.kt0 * kstep + (cur.hb > 0 ? hstep : (size_t)0);
    S.a_ready(cur);
    if constexpr (SP2) {
        PG8_STAGE(PG8_SB(0, 0), cB, voffB); PG8_STAGE(PG8_SB(0, 1), cB + hstep, voffB); PG8_STAGE(PG8_SA(0, 0), cA, voffA); PG8_STAGE(PG8_SA(0, 1), cA + hstep, voffA);
        if (wr == 1) PG8_BAR;
        PG8_WAIT_V(2); PG8_BAR;
        PG8_STAGE(PG8_SB(1, 0), cB + kstep, voffB); PG8_STAGE(PG8_SA(1, 0), cA + kstep, voffA); PG8_STAGE(PG8_SB(1, 1), cB + hstep + kstep, voffB);
        PG8_WAIT_V(6); PG8_BAR;
    } else {
        PG8_STAGE(PG8_SB(0, 0), cB, voffB); PG8_STAGE(PG8_SA(0, 0), cA, voffA); PG8_STAGE(PG8_SB(0, 1), cB + hstep, voffB); PG8_STAGE(PG8_SA(0, 1), cA + hstep, voffA);
        if (wr == 1) PG8_BAR;
        PG8_WAIT_V(4); PG8_BAR;
        PG8_STAGE(PG8_SB(1, 0), cB + kstep, voffB); PG8_STAGE(PG8_SA(1, 0), cA + kstep, voffA); PG8_STAGE(PG8_SB(1, 1), cB + hstep + kstep, voffB);
        PG8_WAIT_V(6); PG8_BAR;
    }
    for (;;) {
        const bool has_next = S.next(ui + 1, nxt);
        const char* nA = has_next ? (const char*)g.A + (size_t)nxt.pm * tstep + (size_t)nxt.kt0 * kstep + (nxt.ha > 0 ? hstep : (size_t)0) : cA; const char* nB = has_next ? (const char*)g.Bt + (size_t)nxt.pn * tstep + (size_t)nxt.kt0 * kstep + (nxt.hb > 0 ? hstep : (size_t)0) : cB;
        const typename Epi::Pf pf = E.prefetch(cur, wr, fr);
        const int nt = cur.nkt; const bool doA1 = cur.ha < 0, doB1 = cur.hb < 0;
        for (int t = 0; t < nt; t += 2) {
            const bool last = (t == nt - 2);
            const char* a1 = cA + (size_t)(t + 1) * kstep;
            const char* a2 = last ? nA : cA + (size_t)(t + 2) * kstep; const char* b2 = last ? nB : cB + (size_t)(t + 2) * kstep;
            const char* a3 = a2 + kstep; const char* b3 = b2 + kstep;
            if (last && has_next) S.a_ready(nxt);
            if constexpr (SP2) {
            PG8_LDB(B0, 0, 0); PG8_LDB(B1, 0, 1); PG8_SCHED; PG8_LDA(At, 0, 0); PG8_STAGE(PG8_SA(1, 1), a1 + hstep, voffA);
            PG8_WAIT_V(8); PG8_WAIT_L(0); PG8_BAR; PG8_MMA(0, 0, At, B0); if (doB1) PG8_MMA(0, 1, At, B1); PG8_BAR; PG8_SCHED;
            PG8_LDA(At, 0, 1); PG8_STAGE(PG8_SB(0, 0), b2, voffB); PG8_STAGE(PG8_SB(0, 1), b2 + hstep, voffB); PG8_STAGE(PG8_SA(0, 0), a2, voffA);
            PG8_WAIT_V(8); PG8_WAIT_L(0); PG8_BAR; if (doA1) { PG8_MMA(1, 0, At, B0); if (doB1) PG8_MMA(1, 1, At, B1); } PG8_BAR; PG8_SCHED;
            PG8_LDB(B0, 1, 0); PG8_LDB(B1, 1, 1); PG8_SCHED; PG8_LDA(At, 1, 0); PG8_STAGE(PG8_SA(0, 1), a2 + hstep, voffA);
            PG8_WAIT_V(8); PG8_WAIT_L(0); PG8_BAR; PG8_MMA(0, 0, At, B0); if (doB1) PG8_MMA(0, 1, At, B1); PG8_BAR; PG8_SCHED;
            PG8_LDA(At, 1, 1); PG8_STAGE(PG8_SB(1, 0), b3, voffB); PG8_STAGE(PG8_SB(1, 1), b3 + hstep, voffB); PG8_STAGE(PG8_SA(1, 0), a3, voffA);
            PG8_WAIT_V(8); PG8_WAIT_L(0); PG8_BAR; if (doA1) { PG8_MMA(1, 0, At, B0); if (doB1) PG8_MMA(1, 1, At, B1); } PG8_BAR; PG8_SCHED;
            } else {
            PG8_LDB(B0, 0, 0); PG8_SCHED; PG8_LDA(At, 0, 0); PG8_STAGE(PG8_SA(1, 1), a1 + hstep, voffA);
            PG8_WAIT_L(8); PG8_BAR; PG8_WAIT_L(0); PG8_MMA(0, 0, At, B0); PG8_BAR; PG8_SCHED;
            PG8_LDB(B1, 0, 1); PG8_STAGE(PG8_SB(0, 0), b2, voffB);
            PG8_BAR; PG8_WAIT_L(0); PG8_MMA(0, 1, At, B1); PG8_BAR;
            PG8_LDA(At, 0, 1); PG8_STAGE(PG8_SA(0, 0), a2, voffA);
            PG8_BAR; PG8_WAIT_L(0); PG8_MMA(1, 0, At, B0); PG8_BAR; PG8_SCHED;
            PG8_STAGE(PG8_SB(0, 1), b2 + hstep, voffB);
            PG8_WAIT_V(6); PG8_BAR; PG8_MMA(1, 1, At, B1); PG8_BAR;
            PG8_LDB(B0, 1, 0); PG8_SCHED; PG8_LDA(At, 1, 0); PG8_STAGE(PG8_SA(0, 1), a2 + hstep, voffA);
            PG8_WAIT_L(8); PG8_BAR; PG8_WAIT_L(0); PG8_MMA(0, 0, At, B0); PG8_BAR; PG8_SCHED;
            PG8_LDB(B1, 1, 1); PG8_STAGE(PG8_SB(1, 0), b3, voffB);
            PG8_BAR; PG8_WAIT_L(0); PG8_MMA(0, 1, At, B1); PG8_BAR;
            PG8_LDA(At, 1, 1); PG8_STAGE(PG8_SA(1, 0), a3, voffA);
            PG8_BAR; PG8_WAIT_L(0); PG8_MMA(1, 0, At, B0); PG8_BAR; PG8_SCHED;
            PG8_STAGE(PG8_SB(1, 1), b3 + hstep, voffB);
            PG8_WAIT_V(6); PG8_BAR; PG8_MMA(1, 1, At, B1); PG8_BAR;
            }
        }
        if constexpr (ALIGN_EPI) { if (wr == 0) PG8_BAR; }
        if constexpr (!Epi::AFTER_DRAIN) { E(acc, cur, wr, wc, fr, fq, pf); S.done(cur); }
        if (!has_next) break;
#pragma unroll
        for (int a = 0; a < 2; ++a)
#pragma unroll
            for (int b = 0; b < 2; ++b)
#pragma unroll
                for (int m = 0; m < 4; ++m)
#pragma unroll
                    for (int n = 0; n < 2; ++n) acc[a][b][m][n] = (f32x4){0.f, 0.f, 0.f, 0.f};
        cur = nxt; cA = nA; cB = nB; ++ui;
        if constexpr (ALIGN_EPI) { if (wr == 1) PG8_BAR; }
    }
    PG8_WAIT_V(0);
    if constexpr (!ALIGN_EPI) { if (wr == 0) PG8_BAR; }
    PG8_BAR;
    if constexpr (Epi::AFTER_DRAIN) { E.fused(acc, cur, wr, wc, fr, fq, lds, wid, lane); S.done(cur); }
#undef PG8_SA
#undef PG8_SB
#undef PG8_STAGE
#undef PG8_LDA
#undef PG8_LDB
#undef PG8_MMA
#undef PG8_WAIT_V
#undef PG8_WAIT_L
#undef PG8_BAR
#undef PG8_SCHED
}
}
namespace att {
using bf16 = __hip_bfloat16;
constexpr int   D = 128, NW = 8, QBLK = 32, KVBLK = 64;
constexpr float SCALE = 0.088388347648318440f;
constexpr float THR = 8.f;
constexpr int SDEPTH = 2;
constexpr int LDQ = 1536, LDK = 1536, LDO = 1024;
constexpr size_t SHM_V = KVBLK * D * 2, SHM_K = KVBLK * D * 2, SHM_ATTN = 3 * SHM_V + 3 * SHM_K + NW * 64 * 4;

using bf16x8 = __attribute__((ext_vector_type(8))) short;
using s16x4  = __attribute__((ext_vector_type(4))) short;
using f32x16 = __attribute__((ext_vector_type(16))) float;
using f32x8  = __attribute__((ext_vector_type(8))) float;
using u32x4  = __attribute__((ext_vector_type(4))) unsigned;
#define KSWZ(row, colB) ((row) * 256 + ((colB) ^ (((row) & 7) << 4)))
#define SBAR() __builtin_amdgcn_sched_barrier(0)
__device__ __forceinline__ int crow(int r, int hi) { return (r & 3) + 8 * (r >> 2) + 4 * hi; }
__device__ __forceinline__ unsigned cvtpk(float lo, float hi) {
  unsigned r; asm volatile("v_cvt_pk_bf16_f32 %0, %1, %2" : "=v"(r) : "v"(lo), "v"(hi)); return r;
}
template <typename TIn> struct Stage;
template <> struct Stage<bf16>  { using T = bf16x8;
  __device__ static __forceinline__ T ld8(const bf16* p) { return *reinterpret_cast<const bf16x8*>(p); }
  __device__ static __forceinline__ bf16x8 tobf(T x) { return x; } };
template <> struct Stage<float> { using T = f32x8;
  __device__ static __forceinline__ T ld8(const float* p) { return *reinterpret_cast<const f32x8*>(p); }
  __device__ static __forceinline__ bf16x8 tobf(T x) {
    u32x4 w = {cvtpk(x[0], x[1]), cvtpk(x[2], x[3]), cvtpk(x[4], x[5]), cvtpk(x[6], x[7])}; return *reinterpret_cast<bf16x8*>(&w); } };

__device__ __forceinline__ void partialSM(f32x16& p0, f32x16& p1, float& m_reg, float& mn, float& alpha) {
  constexpr float C = SCALE * 1.4426950408889634f;
  float pmax = p0[0]; for (int r = 1; r < 16; ++r) pmax = fmaxf(pmax, p0[r]); for (int r = 0; r < 16; ++r) pmax = fmaxf(pmax, p1[r]);
  { auto rr = __builtin_amdgcn_permlane32_swap(__float_as_uint(pmax), __float_as_uint(pmax), false, false);
    pmax = fmaxf(__uint_as_float(rr[0]), __uint_as_float(rr[1])); }
  if (__builtin_expect(__all(pmax - m_reg <= THR / SCALE), 1)) { mn = m_reg; alpha = 1.f; }
  else { mn = fmaxf(m_reg, pmax); alpha = __builtin_amdgcn_exp2f((m_reg - mn) * C); m_reg = mn; }
  float mnC = -mn * C;
  for (int r = 0; r < 16; ++r) p0[r] = fmaf(p0[r], C, mnC); for (int r = 0; r < 16; ++r) p1[r] = fmaf(p1[r], C, mnC);
  for (int r = 0; r < 16; ++r) p0[r] = __builtin_amdgcn_exp2f(p0[r]);
}
__device__ __forceinline__ void partialSM_fixed(f32x16& p0, f32x16& p1, float mnC) {
  constexpr float C = SCALE * 1.4426950408889634f;
  (void)mnC; (void)p1;
  for (int r = 0; r < 16; ++r) p0[r] = __builtin_amdgcn_exp2f(p0[r]);
}
__device__ __forceinline__ void finishSM(f32x16& p0, f32x16& p1, float alpha, float& l_reg, bf16x8& pa0, bf16x8& pa1, bf16x8& pa2, bf16x8& pa3) {
  for (int r = 0; r < 16; ++r) p1[r] = __builtin_amdgcn_exp2f(p1[r]);
  float ps = 0; for (int r = 0; r < 16; ++r) ps += p0[r]; for (int r = 0; r < 16; ++r) ps += p1[r];
  { auto rr = __builtin_amdgcn_permlane32_swap(__float_as_uint(ps), __float_as_uint(ps), false, false);
    ps = __uint_as_float(rr[0]) + __uint_as_float(rr[1]); }
  l_reg = l_reg * alpha + ps;
#define PK4(P, BASE, OUT) do { unsigned a0 = cvtpk(P[BASE + 0], P[BASE + 1]), a1 = cvtpk(P[BASE + 2], P[BASE + 3]);   \
    unsigned b0 = cvtpk(P[BASE + 4], P[BASE + 5]), b1 = cvtpk(P[BASE + 6], P[BASE + 7]);                              \
    auto r0 = __builtin_amdgcn_permlane32_swap(a0, b0, false, false); auto r1 = __builtin_amdgcn_permlane32_swap(a1, b1, false, false); \
    u32x4 w = {r0[0], r1[0], r0[1], r1[1]}; OUT = *reinterpret_cast<bf16x8*>(&w); } while (0)
  PK4(p0, 0, pa0); PK4(p0, 8, pa1); PK4(p1, 0, pa2); PK4(p1, 8, pa3);
#undef PK4
}
__device__ __forceinline__ void qkt(f32x16& p0, f32x16& p1, const bf16* Ks, const bf16x8* qr, int r32, int hi, const f32x16& iv) {
#pragma unroll
  for (int d0 = 0; d0 < 8; ++d0) { int cb = (d0 * 16 + hi * 8) * 2;
    bf16x8 b0 = *reinterpret_cast<const bf16x8*>((const char*)Ks + KSWZ(r32, cb));
    bf16x8 b1 = *reinterpret_cast<const bf16x8*>((const char*)Ks + KSWZ(32 + r32, cb));
    p0 = __builtin_amdgcn_mfma_f32_32x32x16_bf16(b0, qr[d0], d0 == 0 ? iv : p0, 0, 0, 0);
    p1 = __builtin_amdgcn_mfma_f32_32x32x16_bf16(b1, qr[d0], d0 == 0 ? iv : p1, 0, 0, 0); }
}
__device__ __forceinline__ int v_st(int k, int c) { const int kk = (k & ~0xC) | ((k & 4) << 1) | ((k & 8) >> 1); return ((kk >> 3) * 4 + (c >> 5)) * 512 + ((kk & 7) * 32 + (c & 31)) * 2; }
__device__ __forceinline__ int v_rd_base(int lane) { return ((lane & 3) << 3) | (((lane >> 2) & 3) << 6) | (((lane >> 4) & 1) << 5) | (((lane >> 5) & 1) << 8); }
constexpr int v_rd_off(int d0, int ks, int half) { return d0 * 512 + ks * 4096 + half * 2048; }
template <int OFF> __device__ __forceinline__ s16x4 tr_read(int vb) {
  s16x4 r; asm volatile("ds_read_b64_tr_b16 %0, %1 offset:%2" : "=&v"(r) : "v"(vb), "i"(OFF) : "memory"); return r;
}
template <int D0> __device__ __forceinline__ void pv_one(f32x16& od, int vb, bf16x8 pa0, bf16x8 pa1, bf16x8 pa2, bf16x8 pa3) {
  const s16x4 l0 = tr_read<v_rd_off(D0, 0, 0)>(vb), h0 = tr_read<v_rd_off(D0, 0, 1)>(vb), l1 = tr_read<v_rd_off(D0, 1, 0)>(vb), h1 = tr_read<v_rd_off(D0, 1, 1)>(vb);
  const s16x4 l2 = tr_read<v_rd_off(D0, 2, 0)>(vb), h2 = tr_read<v_rd_off(D0, 2, 1)>(vb), l3 = tr_read<v_rd_off(D0, 3, 0)>(vb), h3 = tr_read<v_rd_off(D0, 3, 1)>(vb);
  asm volatile("s_waitcnt lgkmcnt(0)" ::: "memory"); SBAR();
#define PK(L, H) (bf16x8){L[0], L[1], L[2], L[3], H[0], H[1], H[2], H[3]}
  od = __builtin_amdgcn_mfma_f32_32x32x16_bf16(pa0, PK(l0, h0), od, 0, 0, 0);
  od = __builtin_amdgcn_mfma_f32_32x32x16_bf16(pa1, PK(l1, h1), od, 0, 0, 0);
  od = __builtin_amdgcn_mfma_f32_32x32x16_bf16(pa2, PK(l2, h2), od, 0, 0, 0);
  od = __builtin_amdgcn_mfma_f32_32x32x16_bf16(pa3, PK(l3, h3), od, 0, 0, 0);
#undef PK
}
__device__ __forceinline__ void pv_d0(f32x16* o, int vb, bf16x8 pa0, bf16x8 pa1, bf16x8 pa2, bf16x8 pa3) {
  pv_one<0>(o[0], vb, pa0, pa1, pa2, pa3); pv_one<1>(o[1], vb, pa0, pa1, pa2, pa3); pv_one<2>(o[2], vb, pa0, pa1, pa2, pa3); pv_one<3>(o[3], vb, pa0, pa1, pa2, pa3);
}

template <typename TQ>
__device__ __forceinline__ void attn_dense_body(const TQ* __restrict__ Qb, const bf16* __restrict__ Kh, const bf16* __restrict__ Vh,
                                                bf16* __restrict__ Ob, int seq, char* lds, float mraw) {
  using SQ = Stage<TQ>;
  const float mnC = -mraw * (SCALE * 1.4426950408889634f);
  f32x16 iv; for (int r = 0; r < 16; ++r) iv[r] = mnC;
  typedef __attribute__((address_space(3))) unsigned lds_u32;
  const int tid = opaque_tid(), wid = __builtin_amdgcn_readfirstlane(tid >> 6), lane = tid & 63, r32 = lane & 31, hi = lane >> 5;
  const unsigned ldsb = (unsigned)(uintptr_t)lds;
  bf16* V_lds = (bf16*)lds; bf16* K_lds = (bf16*)(lds + 3 * SHM_V);
  float* ws = (float*)(lds + 3 * SHM_V + 3 * SHM_K) + wid * 64; float* li_l = ws; float* al_l = ws + 32;
  float l_reg = 0; f32x16 o[4] = {}; bf16x8 qr[8];
  const TQ* Qw = Qb + (long)(wid * QBLK + r32) * LDQ + hi * 8;
#pragma unroll
  for (int d0 = 0; d0 < 8; ++d0) qr[d0] = SQ::tobf(SQ::ld8(Qw + d0 * 16));
  long ksrc[2], vsrc[2];
#pragma unroll
  for (int t = 0; t < 2; ++t) { const int q = (wid * 2 + t) * 64 + lane;
    { const int row = q >> 4, c = (q & 15) ^ (row & 7); ksrc[t] = (long)row * LDK + c * 8; }
    { const int off = q * 16, sub = off >> 9, kk = (sub >> 2) * 8 + ((off & 511) >> 6), cc = (sub & 3) * 32 + ((off & 63) >> 1);
      const int k = (kk & ~0xC) | ((kk & 4) << 1) | ((kk & 8) >> 1); vsrc[t] = (long)k * LDK + cc; } }
  const int vb0 = (int)ldsb + v_rd_base(lane);
#define DMA_TILE(tile, buf) do { const bf16* kp_ = Kh + (long)(tile) * KVBLK * LDK; const bf16* vp_ = Vh + (long)(tile) * KVBLK * LDK; _Pragma("unroll") for (int t_ = 0; t_ < 2; ++t_) { \
      __builtin_amdgcn_global_load_lds((const unsigned*)(kp_ + ksrc[t_]), (lds_u32*)(size_t)(ldsb + 3 * (unsigned)SHM_V + (unsigned)(buf) * (unsigned)SHM_K + (unsigned)(wid * 2 + t_) * 1024u), 16, 0, 0); \
      __builtin_amdgcn_global_load_lds((const unsigned*)(vp_ + vsrc[t_]), (lds_u32*)(size_t)(ldsb + (unsigned)(buf) * (unsigned)SHM_V + (unsigned)(wid * 2 + t_) * 1024u), 16, 0, 0); } } while (0)
#define KBUF(b) ((bf16*)((char*)K_lds + (b) * SHM_K))
#define VBUF(b) (vb0 + (b) * (int)SHM_V)
#define LANDED_BAR() do { asm volatile("s_waitcnt vmcnt(0)" ::: "memory"); __syncthreads(); } while (0)
#define RESC(a) do { if (__any((a) < 1.f)) { if (hi == 0) al_l[r32] = (a); asm volatile("s_waitcnt lgkmcnt(0)" ::: "memory"); \
    for (int d = 0; d < 4; ++d) for (int r = 0; r < 16; ++r) o[d][r] *= al_l[crow(r, hi)]; } } while (0)
  f32x16 pA0, pA1, pB0, pB1; bf16x8 pa0, pa1, pa2, pa3; const int NT = seq / KVBLK;
  DMA_TILE(0, 0); DMA_TILE(1, 1); DMA_TILE(2, 2);
  asm volatile("s_waitcnt vmcnt(8)" ::: "memory"); __syncthreads();
  qkt(pA0, pA1, KBUF(0), qr, r32, hi, iv); partialSM_fixed(pA0, pA1, mnC);
  asm volatile("s_waitcnt vmcnt(4)" ::: "memory"); __syncthreads();
  int bprev = 0, bcur = 1, bnext = 2;
  for (int j = 1; j + 1 < NT; j += 2) {
    SBAR(); qkt(pB0, pB1, KBUF(bcur), qr, r32, hi, iv);
    finishSM(pA0, pA1, 1.f, l_reg, pa0, pa1, pa2, pa3); SBAR();
    pv_d0(o, VBUF(bprev), pa0, pa1, pa2, pa3); partialSM_fixed(pB0, pB1, mnC);
    LANDED_BAR();
    if (j + 2 < NT) DMA_TILE(j + 2, bprev);
    SBAR(); qkt(pA0, pA1, KBUF(bnext), qr, r32, hi, iv);
    finishSM(pB0, pB1, 1.f, l_reg, pa0, pa1, pa2, pa3); SBAR();
    pv_d0(o, VBUF(bcur), pa0, pa1, pa2, pa3); partialSM_fixed(pA0, pA1, mnC);
    LANDED_BAR();
    if (j + 3 < NT) DMA_TILE(j + 3, bcur);
    { const int t0_ = bprev; bprev = bnext; bnext = bcur; bcur = t0_; }
  }
  SBAR(); qkt(pB0, pB1, KBUF(bcur), qr, r32, hi, iv);
  finishSM(pA0, pA1, 1.f, l_reg, pa0, pa1, pa2, pa3); SBAR();
  pv_d0(o, VBUF(bprev), pa0, pa1, pa2, pa3); partialSM_fixed(pB0, pB1, mnC);
  finishSM(pB0, pB1, 1.f, l_reg, pa0, pa1, pa2, pa3); SBAR();
  pv_d0(o, VBUF(bcur), pa0, pa1, pa2, pa3);
  if (hi == 0) li_l[r32] = l_reg; asm volatile("s_waitcnt lgkmcnt(0)" ::: "memory");
  float rli[16];
#pragma unroll
  for (int r = 0; r < 16; ++r) rli[r] = __builtin_amdgcn_rcpf(li_l[crow(r, hi)]);
  bf16* Ow = Ob + (long)(wid * QBLK) * LDO;
#pragma unroll
  for (int r = 0; r < 16; ++r) { int orow = crow(r, hi);
#pragma unroll
    for (int d0 = 0; d0 < 4; ++d0) { const float v = o[d0][r] * rli[r]; const float nb = __shfl_xor(v, 1);
      if (!(r32 & 1)) *reinterpret_cast<unsigned*>(Ow + (long)orow * LDO + d0 * 32 + r32) = cvtpk(v, nb); } }
#undef DMA_TILE
#undef KBUF
#undef VBUF
#undef LANDED_BAR
#undef RESC
}
}

constexpr int NB = 8, SEQ = 4096, CTX = 256, DM = 1024, FF = 2816, NFF2 = 2 * FF, NQKV = 1536, NCONV = 3072;
constexpr int TPB = CTX + SEQ;
constexpr int M = NB * TPB;
constexpr int NMOD = 9 * 1024;
constexpr int MODW = 4 * NMOD;
constexpr int KSPLIT = 8;
constexpr int NWAVES = 8, NTHREADS = 512;
constexpr float EPS = 1e-6f;
constexpr size_t al256(size_t x) { return (x + 255) / 256 * 256; }
constexpr size_t WS_BAR = 0, BAR_BYTES = 16384;
constexpr size_t WS_MOD = BAR_BYTES;
constexpr size_t WS_ROPE = al256(WS_MOD + (size_t)9 * MODW * 4);
constexpr size_t WS_PART = al256(WS_ROPE + 2 * 64 * 32 * 4);
constexpr size_t WS_WFI = al256(WS_PART + (size_t)KSPLIT * 9 * MODW * 4);
constexpr size_t WS_WFO = al256(WS_WFI + (size_t)8 * NFF2 * DM * 2);
constexpr size_t WS_WCI = al256(WS_WFO + (size_t)8 * DM * FF * 2);
constexpr size_t WS_WCO = al256(WS_WCI + (size_t)2 * NCONV * DM * 2);
constexpr size_t WS_WQKV = al256(WS_WCO + (size_t)2 * DM * DM * 2);
constexpr size_t WS_WO = al256(WS_WQKV + (size_t)2 * NQKV * DM * 2);
constexpr size_t WS_XRES = al256(WS_WO + (size_t)2 * DM * DM * 2);
constexpr size_t WS_XN = al256(WS_XRES + (size_t)M * DM * 4);
constexpr size_t WS_BIG = al256(WS_XN + (size_t)M * DM * 2);
constexpr size_t WS_XB = al256(WS_BIG + (size_t)M * NCONV * 2);
constexpr size_t WS_RSS = al256(WS_XB + (size_t)M * DM * 2);
constexpr size_t WS_SW = al256(WS_RSS + (size_t)12 * M * 4);
constexpr size_t WS_END = al256(WS_SW + (size_t)12 * 9 * NFF2 * 4);
constexpr int LDS_BYTES = 131072 + 1024;

typedef unsigned short bf16;
typedef unsigned v4u __attribute__((ext_vector_type(4)));
typedef unsigned v2u __attribute__((ext_vector_type(2)));
typedef float f32x4 __attribute__((ext_vector_type(4)));
typedef float f32x2 __attribute__((ext_vector_type(2)));
#define LAS __attribute__((address_space(3)))
#define LDS_WAIT() asm volatile("s_waitcnt lgkmcnt(0)" ::: "memory")
__device__ __forceinline__ unsigned pk2(float lo, float hi) { return pg8::cvt_pk_bf16(lo, hi); }
__device__ __forceinline__ float bflo(unsigned w) { return __uint_as_float(w << 16); }
__device__ __forceinline__ float bfhi(unsigned w) { return __uint_as_float(w & 0xffff0000u); }
__device__ __forceinline__ float wave_sum(float v) {
#pragma unroll
    for (int o = 1; o < 64; o <<= 1) v += __shfl_xor(v, o);
    return v;
}

#define XB_TMO      128
#define XB_XCNT(j)  (256  + 64 * (j))
#define XB_XSUB(j)  (1280 + 64 * (j))
#define XB_XGEN(j)  (2304 + 64 * (j))
#define XB_TOP      3328
#define XB_TOPGEN   3392
#define XCD_BAR_WORDS 3456
#define XB_SPIN_CAP (1u << 18)

__device__ __forceinline__ unsigned xb_ld(unsigned* p)              { return __hip_atomic_load(p, __ATOMIC_RELAXED, __HIP_MEMORY_SCOPE_AGENT); }
__device__ __forceinline__ unsigned xb_add(unsigned* p, unsigned v) { return __hip_atomic_fetch_add(p, v, __ATOMIC_RELAXED, __HIP_MEMORY_SCOPE_AGENT); }
__device__ __forceinline__ unsigned xb_xcc_id() { return (unsigned)__builtin_amdgcn_s_getreg((3 << 11) | 20) & 0xFu; }
#define XB_SPIN(cond, bar) do { unsigned _sp = 0; while (cond) { __builtin_amdgcn_s_sleep(1); \
    if ((++_sp & 255u) == 0u) { if (xb_ld(&(bar)[XB_TMO])) break; if (_sp > XB_SPIN_CAP) { atomicAdd(&(bar)[XB_TMO], 1u); break; } } } } while (0)

struct XcdBarrier {
    unsigned* bar; unsigned x;
    volatile LAS unsigned* st;
};

__device__ __forceinline__ XcdBarrier xcd_barrier_post(unsigned* bar, volatile LAS unsigned* st) {
    XcdBarrier b; b.bar = bar; b.x = xb_xcc_id(); b.st = st;
    if (threadIdx.x == 0) (void)xb_add(&bar[XB_XCNT(b.x)], 1u);
    return b;
}
__device__ __forceinline__ void xcd_barrier_complete(unsigned* bar, unsigned x, unsigned& nloc, unsigned& nx) {
    const unsigned G = gridDim.x * gridDim.y * gridDim.z;
    unsigned sum, cnt, mine, sp = 0u;
    for (;;) {
        sum = 0u; cnt = 0u; mine = 0u;
#pragma unroll
        for (unsigned j = 0; j < 16; ++j) { const unsigned c = xb_ld(&bar[XB_XCNT(j)]); sum += c; cnt += (c > 0u) ? 1u : 0u; mine = (j == x) ? c : mine; }
        if (sum == G) break;
        __builtin_amdgcn_s_sleep(1);
        if ((++sp & 255u) == 0u) { if (xb_ld(&bar[XB_TMO])) break; if (sp > XB_SPIN_CAP) { atomicAdd(&bar[XB_TMO], 1u); break; } }
    }
    nloc = mine > 0u ? mine : 1u; nx = cnt > 0u ? cnt : 1u;
}

__device__ __forceinline__ void xcd_barrier(const XcdBarrier& b) {
    asm volatile("s_waitcnt vmcnt(0)" ::: "memory");
    __syncthreads();
    if (threadIdx.x == 0) {
        unsigned* bar = b.bar;
        __builtin_amdgcn_s_waitcnt(0);
        unsigned nloc = b.st[0], nx = b.st[1];
        if (nloc == 0u) { xcd_barrier_complete(bar, b.x, nloc, nx); b.st[0] = nloc; b.st[1] = nx; }
        const unsigned old = xb_add(&bar[XB_XSUB(b.x)], 1u);
        const unsigned gen = old / nloc;
        if (old + 1u == (gen + 1u) * nloc) {
            __builtin_amdgcn_fence(__ATOMIC_RELEASE, "agent");
            asm volatile("s_waitcnt vmcnt(0)" ::: "memory");
            const unsigned og = xb_add(&bar[XB_TOP], 1u);
            const unsigned tg = og / nx;
            if (og + 1u == (tg + 1u) * nx) xb_add(&bar[XB_TOPGEN], 1u);
            else XB_SPIN(xb_ld(&bar[XB_TOPGEN]) == tg, bar);
            __builtin_amdgcn_fence(__ATOMIC_ACQUIRE, "agent");
            xb_add(&bar[XB_XGEN(b.x)], 1u);
            asm volatile("s_waitcnt vmcnt(0)" ::: "memory");
        } else {
            XB_SPIN(xb_ld(&bar[XB_XGEN(b.x)]) == gen, bar);
            __builtin_amdgcn_fence(__ATOMIC_ACQUIRE, "agent");
            asm volatile("s_waitcnt vmcnt(0)" ::: "memory");
        }
    }
    __syncthreads();
}

struct Args {
    const float *x, *c, *ctx, *c_ctx, *ada_w, *ada_b, *norm_g, *final_g, *ffn_w_in, *ffn_w_out, *conv_w_in, *conv_w, *conv_w_out, *attn_w_qkv, *attn_q_g, *attn_k_g, *attn_w_o;
    float* out; unsigned char* ws;
};
__device__ __forceinline__ const void* karg_ptr(size_t off) { const char __attribute__((address_space(4)))* kp = (const char __attribute__((address_space(4)))*)__builtin_amdgcn_kernarg_segment_ptr(); asm volatile("" : "+s"(kp)); return *(const void* const __attribute__((address_space(4)))*)(kp + off); }
#define KARG(name) ((decltype(Args::name))karg_ptr(offsetof(Args, name)))

__device__ __forceinline__ void transpose_item(const float* W, int K, int N, bf16* WT, int mode, LAS float* scr, int item, int lane) {
    const int nblk = N / 32, kb = item / nblk, nb = item % nblk, k0 = 64 * kb, n0 = 32 * nb;
    int d0 = n0;
    if (mode == 1) { const int up = n0 >= FF ? 1 : 0, j = n0 - up * FF; d0 = 256 * (j >> 7) + 128 * up + (j & 127); }
    if (mode == 2 && n0 >= DM) { const int isv = n0 >= 2 * DM ? 1 : 0, j = n0 - DM - isv * DM; d0 = DM + 256 * (j >> 7) + 128 * isv + (j & 127); }
    { f32x4 t4[8]; const int nn = 4 * (lane & 7);
#pragma unroll
      for (int i = 0; i < 8; ++i) t4[i] = __builtin_nontemporal_load((const f32x4*)(W + (size_t)(k0 + 8 * i + (lane >> 3)) * N + n0 + nn));
#pragma unroll
      for (int i = 0; i < 8; ++i) { LAS float* d = scr + (8 * i + (lane >> 3)) * 33 + nn; d[0] = t4[i].x; d[1] = t4[i].y; d[2] = t4[i].z; d[3] = t4[i].w; } }
    LDS_WAIT(); asm volatile("" ::: "memory");
    const int c = lane & 7;
#pragma unroll
    for (int j = 0; j < 4; ++j) { const int n = (lane >> 3) + 8 * j; const LAS float* s = scr + (8 * c) * 33 + n;
        v4u o; o.x = pk2(s[0 * 33], s[1 * 33]); o.y = pk2(s[2 * 33], s[3 * 33]); o.z = pk2(s[4 * 33], s[5 * 33]); o.w = pk2(s[6 * 33], s[7 * 33]);
        __builtin_nontemporal_store(o, (v4u*)(WT + (size_t)(d0 + n) * K + k0 + 8 * c)); }
    LDS_WAIT(); asm volatile("" ::: "memory");
}

struct Ctx {
    LAS unsigned char* lds;
    int G, NGW, NT;
};
#define PHASE_IDS const int tid_ = opaque_tid(), lane_ = tid_ & 63, wave_ = __builtin_amdgcn_readfirstlane(tid_ >> 6), gw_ = (int)blockIdx.x * NWAVES + wave_, gt_ = (int)blockIdx.x * NTHREADS + tid_; (void)lane_; (void)gw_; (void)gt_

__device__ __forceinline__ void p0_weights(const Args& a, const Ctx& F) {
    PHASE_IDS;
    LAS float* scr = (LAS float*)(F.lds + wave_ * 16384);
    constexpr int I_FI = (DM / 64) * (NFF2 / 32), I_FO = (FF / 64) * (DM / 32), I_CI = (DM / 64) * (NCONV / 32), I_SQ = (DM / 64) * (DM / 32), I_QKV = (DM / 64) * (NQKV / 32);
    constexpr int NITEMS = 8 * I_FI + 8 * I_FO + 2 * I_CI + 2 * I_SQ + 2 * I_QKV + 2 * I_SQ;
    for (int it = gw_; it < NITEMS; it += F.NGW) {
        int r = it;
        if (r < 8 * I_FI) { const int m = r / I_FI; r -= m * I_FI; transpose_item(KARG(ffn_w_in) + (size_t)m * DM * NFF2, DM, NFF2, (bf16*)(KARG(ws) + WS_WFI) + (size_t)m * NFF2 * DM, 1, scr, r, lane_); continue; } r -= 8 * I_FI;
        if (r < 8 * I_FO) { const int m = r / I_FO; r -= m * I_FO; transpose_item(KARG(ffn_w_out) + (size_t)m * FF * DM, FF, DM, (bf16*)(KARG(ws) + WS_WFO) + (size_t)m * DM * FF, 0, scr, r, lane_); continue; } r -= 8 * I_FO;
        if (r < 2 * I_CI) { const int m = r / I_CI; r -= m * I_CI; transpose_item(KARG(conv_w_in) + (size_t)m * DM * NCONV, DM, NCONV, (bf16*)(KARG(ws) + WS_WCI) + (size_t)m * NCONV * DM, 2, scr, r, lane_); continue; } r -= 2 * I_CI;
        if (r < 2 * I_SQ) { const int m = r / I_SQ; r -= m * I_SQ; transpose_item(KARG(conv_w_out) + (size_t)m * DM * DM, DM, DM, (bf16*)(KARG(ws) + WS_WCO) + (size_t)m * DM * DM, 0, scr, r, lane_); continue; } r -= 2 * I_SQ;
        if (r < 2 * I_QKV) { const int m = r / I_QKV; r -= m * I_QKV; transpose_item(KARG(attn_w_qkv) + (size_t)m * DM * NQKV, DM, NQKV, (bf16*)(KARG(ws) + WS_WQKV) + (size_t)m * NQKV * DM, 0, scr, r, lane_); continue; } r -= 2 * I_QKV;
        { const int m = r / I_SQ; r -= m * I_SQ; transpose_item(KARG(attn_w_o) + (size_t)m * DM * DM, DM, DM, (bf16*)(KARG(ws) + WS_WO) + (size_t)m * DM * DM, 0, scr, r, lane_); }
    }
}

__device__ __forceinline__ void p0_ada_partial(const Args& a, const Ctx& F) {
    PHASE_IDS;
    __syncthreads();
    LAS float* s = (LAS float*)F.lds;
    for (int e = tid_; e < 9 * 1024; e += NTHREADS) { const int b = e >> 10, k = e & 1023; const float v = b < 8 ? KARG(c)[b * 1024 + k] : KARG(c_ctx)[k]; s[e] = v / (1.0f + __expf(-v)); }
    __syncthreads();
    float* part = (float*)(KARG(ws) + WS_PART);
    constexpr int NCG = MODW / 4, KC = 1024 / KSPLIT;
    for (int base_ = 0; base_ < NCG * KSPLIT; base_ += (F.NT >> 4) * 9) {
        const int it = base_ + (gt_ >> 4) * 9 + (gt_ & 15);
        if ((gt_ & 15) < 9 && it < NCG * KSPLIT) {
        const int cgp = it % NCG, kc = it / NCG, n = 4 * cgp, layer = n / NMOD, nn = n - layer * NMOD;
        const float* wp = KARG(ada_w) + ((size_t)layer * 1024 + kc * KC) * NMOD + nn;
        f32x4 acc[9];
#pragma unroll
        for (int b = 0; b < 9; ++b) acc[b] = (f32x4){0.f, 0.f, 0.f, 0.f};
        for (int k8 = 0; k8 < KC; k8 += 8) {
            f32x4 w[8];
#pragma unroll
            for (int q = 0; q < 8; ++q) w[q] = __builtin_nontemporal_load((const f32x4*)(wp + (size_t)(k8 + q) * NMOD));
#pragma unroll
            for (int b = 0; b < 9; ++b) { const f32x4 s0 = *(const LAS f32x4*)(s + b * 1024 + kc * KC + k8), s1 = *(const LAS f32x4*)(s + b * 1024 + kc * KC + k8 + 4);
                acc[b] = acc[b] + w[0] * s0.x + w[1] * s0.y + w[2] * s0.z + w[3] * s0.w + w[4] * s1.x + w[5] * s1.y + w[6] * s1.z + w[7] * s1.w; }
        }
#pragma unroll
        for (int b = 0; b < 9; ++b) *(f32x4*)(part + ((size_t)(kc * 9 + b)) * MODW + n) = acc[b];
        } }
    __syncthreads();
}
__device__ __forceinline__ void p0_rope_table(const Ctx& F) {
    PHASE_IDS;
    if (gt_ < 64 * 32) { const int pos = gt_ >> 5, f = gt_ & 31; const float inv = powf(10000.0f, -(float)f / 32.0f); const float ang = (float)pos * inv;
        float* t = (float*)(KARG(ws) + WS_ROPE); t[gt_] = cosf(ang); t[2048 + gt_] = sinf(ang); }
}
__device__ __forceinline__ void p1_ada_reduce(const Args& a, const Ctx& F) {
    PHASE_IDS;
    const float* part = (const float*)(KARG(ws) + WS_PART); float* mod = (float*)(KARG(ws) + WS_MOD);
    for (int e = gt_; e < 9 * MODW; e += F.NT) { const int b = e / MODW, n = e - b * MODW; float sacc = KARG(ada_b)[n];
#pragma unroll
        for (int kc = 0; kc < KSPLIT; ++kc) sacc += part[((size_t)(kc * 9 + b)) * MODW + n];
        mod[e] = sacc; }
}

template <int R> __device__ __forceinline__ void prep_rows(int row0, int stride, int lane_, const float* g, const float* modb, const float* x_in, const float* ctx_in, float* xres, bf16* xs, float* rss) {
    f32x4 v[R][4]; float ss[R]; int mi[R];
#pragma unroll
    for (int r = 0; r < R; ++r) { const int row = row0 + r * stride; const int b = row / TPB, t = row - b * TPB; const bool isctx = t < CTX; mi[r] = isctx ? 8 : b;
        const float* src = isctx ? ctx_in + (size_t)(b * CTX + t) * DM : x_in + (size_t)(b * SEQ + t - CTX) * DM;
#pragma unroll
        for (int j = 0; j < 4; ++j) v[r][j] = __builtin_nontemporal_load((const f32x4*)src + lane_ + 64 * j); }
#pragma unroll
    for (int r = 0; r < R; ++r) { float s_ = 0.f;
#pragma unroll
        for (int j = 0; j < 4; ++j) s_ += (v[r][j].x * v[r][j].x + v[r][j].y * v[r][j].y) + (v[r][j].z * v[r][j].z + v[r][j].w * v[r][j].w);
        ss[r] = s_; }
#pragma unroll
    for (int r = 0; r < R; ++r)
#pragma unroll
        for (int j = 0; j < 4; ++j) __builtin_nontemporal_store(v[r][j], (f32x4*)(xres + (size_t)(row0 + r * stride) * DM) + lane_ + 64 * j);
#pragma unroll
    for (int o = 1; o < 64; o <<= 1) {
#pragma unroll
        for (int r = 0; r < R; ++r) ss[r] += __shfl_xor(ss[r], o); }
#pragma unroll
    for (int r = 0; r < R; ++r) { const float* sc = modb + (size_t)mi[r] * MODW + 1024;
        if (lane_ == 0) rss[row0 + r * stride] = ss[r];
#pragma unroll
        for (int j = 0; j < 4; ++j) { const f32x4 gj = ((const f32x4*)g)[lane_ + 64 * j], sj = ((const f32x4*)sc)[lane_ + 64 * j];
            const f32x4 o = v[r][j] * gj * (sj + 1.0f);
            v2u w; w.x = pk2(o.x, o.y); w.y = pk2(o.z, o.w); ((v2u*)(xs + (size_t)(row0 + r * stride) * DM))[lane_ + 64 * j] = w; } }
}
__device__ __forceinline__ void prep_phase(const Args& a, const Ctx& F) {
    PHASE_IDS;
    const float* g = KARG(norm_g); const float* modb = (const float*)(KARG(ws) + WS_MOD);
    float* xres = (float*)(KARG(ws) + WS_XRES); bf16* xs = (bf16*)(KARG(ws) + WS_XN); float* rss = (float*)(KARG(ws) + WS_RSS); const float* x_in = KARG(x); const float* ctx_in = KARG(ctx);
    int row = gw_;
    for (; row + 3 * F.NGW < M; row += 4 * F.NGW) prep_rows<4>(row, F.NGW, lane_, g, modb, x_in, ctx_in, xres, xs, rss);
    for (; row < M; row += F.NGW) prep_rows<1>(row, F.NGW, lane_, g, modb, x_in, ctx_in, xres, xs, rss);
}
__device__ __forceinline__ int sl_cols(int sl) { const int layer = sl / 3, sub = sl - layer * 3; return sub != 1 ? NFF2 : ((layer & 1) ? NQKV : NCONV); }
__device__ __forceinline__ const bf16* sl_weights(unsigned char* ws, int sl) { const int layer = sl / 3, sub = sl - layer * 3;
    if (sub != 1) return (const bf16*)(ws + WS_WFI) + (size_t)(layer * 2 + (sub >> 1)) * NFF2 * DM;
    return (layer & 1) ? (const bf16*)(ws + WS_WQKV) + (size_t)(layer >> 1) * NQKV * DM : (const bf16*)(ws + WS_WCI) + (size_t)(layer >> 1) * NCONV * DM; }
__device__ __forceinline__ void bias_phase(const Args& a, const Ctx& F) {
    PHASE_IDS;
    unsigned char* ws = KARG(ws); const float* mod = (const float*)(ws + WS_MOD); float* sw = (float*)(ws + WS_SW);
    constexpr int NCOLS = 8 * NFF2 + 2 * NCONV + 2 * NQKV;
    const int per = (NCOLS + F.NGW - 1) / F.NGW; const int c0 = gw_ * per; const int c1 = (c0 + per < NCOLS) ? c0 + per : NCOLS;
    int sl = 0, base = 0, cur = -1; float shr[9][16];
#pragma unroll
    for (int mi = 0; mi < 9; ++mi)
#pragma unroll
        for (int k = 0; k < 16; ++k) shr[mi][k] = 0.f;
    for (int c = c0; c < c1; ++c) {
        while (c >= base + sl_cols(sl)) { base += sl_cols(sl); ++sl; }
        if (sl != cur) { cur = sl; const int layer = sl / 3, sub = sl - layer * 3; const float* sh = mod + layer * NMOD + (sub * 3) * 1024 + 16 * lane_;
#pragma unroll
            for (int mi = 0; mi < 9; ++mi)
#pragma unroll
                for (int q = 0; q < 4; ++q) { const f32x4 t4 = *(const f32x4*)(sh + (size_t)mi * MODW + 4 * q); shr[mi][4 * q] = t4.x; shr[mi][4 * q + 1] = t4.y; shr[mi][4 * q + 2] = t4.z; shr[mi][4 * q + 3] = t4.w; } }
        const int n = c - base; const bf16* wrow = sl_weights(ws, sl) + (size_t)n * DM + 16 * lane_;
        const v4u w0 = *(const v4u*)wrow, w1 = *(const v4u*)(wrow + 8);
        float wf[16];
#pragma unroll
        for (int q = 0; q < 4; ++q) { wf[2 * q] = bflo(w0[q]); wf[2 * q + 1] = bfhi(w0[q]); wf[8 + 2 * q] = bflo(w1[q]); wf[8 + 2 * q + 1] = bfhi(w1[q]); }
        float accb[9];
#pragma unroll
        for (int mi = 0; mi < 9; ++mi) { float t_ = 0.f;
#pragma unroll
            for (int k = 0; k < 16; ++k) t_ += wf[k] * shr[mi][k];
            accb[mi] = t_; }
#pragma unroll
        for (int o = 1; o < 64; o <<= 1) {
#pragma unroll
            for (int mi = 0; mi < 9; ++mi) accb[mi] += __shfl_xor(accb[mi], o); }
#pragma unroll
        for (int mi = 0; mi < 9; ++mi) if (lane_ == mi) sw[((size_t)sl * 9 + mi) * NFF2 + n] = accb[mi];
    }
}
template <int R> __device__ __forceinline__ void final_rows(int idx0, int stride, int lane_, const float* xres, const float* fg, float* out) {
    f32x4 v[R][4]; float ss[R];
#pragma unroll
    for (int r = 0; r < R; ++r) { const int idx = idx0 + r * stride, b = idx / SEQ, t = idx - b * SEQ; const float* src = xres + (size_t)(b * TPB + CTX + t) * DM;
#pragma unroll
        for (int j = 0; j < 4; ++j) v[r][j] = __builtin_nontemporal_load((const f32x4*)src + lane_ + 64 * j); }
#pragma unroll
    for (int r = 0; r < R; ++r) { float s_ = 0.f;
#pragma unroll
        for (int j = 0; j < 4; ++j) s_ += (v[r][j].x * v[r][j].x + v[r][j].y * v[r][j].y) + (v[r][j].z * v[r][j].z + v[r][j].w * v[r][j].w);
        ss[r] = s_; }
#pragma unroll
    for (int o = 1; o < 64; o <<= 1) {
#pragma unroll
        for (int r = 0; r < R; ++r) ss[r] += __shfl_xor(ss[r], o); }
#pragma unroll
    for (int r = 0; r < R; ++r) { const float rstd = 1.0f / sqrtf(ss[r] * (1.0f / DM) + EPS);
#pragma unroll
        for (int j = 0; j < 4; ++j) { const f32x4 gj = ((const f32x4*)fg)[lane_ + 64 * j]; __builtin_nontemporal_store(v[r][j] * rstd * gj, (f32x4*)(out + (size_t)(idx0 + r * stride) * DM) + lane_ + 64 * j); } }
}
__device__ __forceinline__ void final_phase(const Args& a, const Ctx& F) {
    PHASE_IDS;
    const float* xres = (const float*)(KARG(ws) + WS_XRES); const float* fg = KARG(final_g); float* out = KARG(out);
    int idx = gw_;
    for (; idx + 3 * F.NGW < NB * SEQ; idx += 4 * F.NGW) final_rows<4>(idx, F.NGW, lane_, xres, fg, out);
    for (; idx < NB * SEQ; idx += F.NGW) final_rows<1>(idx, F.NGW, lane_, xres, fg, out);
}

template <int R> __device__ __forceinline__ void conv_rows(int row0, int lane_, const bf16* bu, bf16* z, const float* cw) {
#pragma unroll
    for (int jj = 0; jj < 2; ++jj) { const int d = 8 * lane_ + 512 * jj;
        v4u ur[R + 2], br[R];
#pragma unroll
        for (int i = 0; i < R + 2; ++i) { const int rr = row0 - 1 + i; const bool ok = rr >= 0 && rr < M; ur[i] = *(const v4u*)(bu + (size_t)(ok ? rr : row0) * 2048 + DM + d); }
#pragma unroll
        for (int i = 0; i < R; ++i) br[i] = *(const v4u*)(bu + (size_t)(row0 + i) * 2048 + d);
        const f32x4 w0a = *(const f32x4*)(cw + d), w0b = *(const f32x4*)(cw + d + 4), w1a = *(const f32x4*)(cw + DM + d), w1b = *(const f32x4*)(cw + DM + d + 4), w2a = *(const f32x4*)(cw + 2 * DM + d), w2b = *(const f32x4*)(cw + 2 * DM + d + 4);
        const float w0[8] = {w0a.x, w0a.y, w0a.z, w0a.w, w0b.x, w0b.y, w0b.z, w0b.w}, w1[8] = {w1a.x, w1a.y, w1a.z, w1a.w, w1b.x, w1b.y, w1b.z, w1b.w}, w2[8] = {w2a.x, w2a.y, w2a.z, w2a.w, w2b.x, w2b.y, w2b.z, w2b.w};
#pragma unroll
        for (int i = 0; i < R; ++i) { const int row = row0 + i, b = row / TPB, t = row - b * TPB; const float mp = (t != 0 && t != CTX) ? 1.f : 0.f, mn = (t != CTX - 1 && t != TPB - 1) ? 1.f : 0.f;
            v4u o;
#pragma unroll
            for (int q = 0; q < 4; ++q) {
                const float ylo = mp * w0[2 * q] * bflo(ur[i][q]) + w1[2 * q] * bflo(ur[i + 1][q]) + mn * w2[2 * q] * bflo(ur[i + 2][q]);
                const float yhi = mp * w0[2 * q + 1] * bfhi(ur[i][q]) + w1[2 * q + 1] * bfhi(ur[i + 1][q]) + mn * w2[2 * q + 1] * bfhi(ur[i + 2][q]);
                o[q] = pk2(bflo(br[i][q]) * ylo, bfhi(br[i][q]) * yhi); }
            *(v4u*)(z + (size_t)row * DM + d) = o; } }
}
__device__ __forceinline__ void conv_phase(const Args& a, const Ctx& F, int j) {
    PHASE_IDS;
    const bf16* bcv = (const bf16*)(KARG(ws) + WS_BIG); bf16* z = (bf16*)(KARG(ws) + WS_XB); const float* cw = KARG(conv_w) + (size_t)j * 3 * DM;
    const int chunk = (M + F.NGW - 1) / F.NGW, r0 = gw_ * chunk, r1 = (r0 + chunk < M) ? r0 + chunk : M;
    int row = r0;
    for (; row + 2 <= r1; row += 2) conv_rows<2>(row, lane_, bcv, z, cw);
    for (; row < r1; ++row) conv_rows<1>(row, lane_, bcv, z, cw);
}

template <int R> __device__ __forceinline__ void normrope_rows(int row0, int stride, int lane, unsigned* qkv, const float* ct, const float* st, f32x2 gq, f32x2 gk) {
    const int axis = lane >> 5, half = (lane >> 4) & 1, f0 = 2 * (lane & 15);
    unsigned raw[R][10]; f32x2 cs[R], sn[R];
#pragma unroll
    for (int r = 0; r < R; ++r) { unsigned* base = qkv + (size_t)(row0 + r * stride) * (NQKV / 2);
#pragma unroll
        for (int h = 0; h < 10; ++h) raw[r][h] = base[h * 64 + lane]; }
#pragma unroll
    for (int r = 0; r < R; ++r) { const int row = row0 + r * stride, b = row / TPB, t = row - b * TPB; const bool isctx = t < CTX; const int tl = isctx ? 0 : t - CTX; const int pos = axis ? (tl & 63) : (tl >> 6);
        cs[r] = *(const f32x2*)(ct + pos * 32 + f0); sn[r] = *(const f32x2*)(st + pos * 32 + f0);
        if (isctx) { cs[r] = (f32x2){1.f, 1.f}; sn[r] = (f32x2){0.f, 0.f}; }
        if (half == 0) sn[r] = -sn[r]; }
#pragma unroll
    for (int r = 0; r < R; ++r) { unsigned* base = qkv + (size_t)(row0 + r * stride) * (NQKV / 2);
        float ssq[10];
#pragma unroll
        for (int h = 0; h < 10; ++h) { const float x0 = bflo(raw[r][h]), x1 = bfhi(raw[r][h]); ssq[h] = x0 * x0 + x1 * x1; }
#pragma unroll
        for (int o = 1; o < 64; o <<= 1) {
#pragma unroll
            for (int h = 0; h < 10; ++h) ssq[h] += __shfl_xor(ssq[h], o); }
#pragma unroll
        for (int h = 0; h < 10; ++h) { const float x0 = bflo(raw[r][h]), x1 = bfhi(raw[r][h]);
            const float rstd = 1.0f / sqrtf(ssq[h] * (1.0f / 128.0f) + EPS);
            const f32x2 gg = h < 8 ? gq : gk; const float y0 = x0 * rstd * gg.x, y1 = x1 * rstd * gg.y;
            const float p0 = __shfl_xor(y0, 16), p1 = __shfl_xor(y1, 16);
            const float qs = h < 8 ? 0.12751743f : 1.0f;
            base[h * 64 + lane] = pk2((y0 * cs[r].x + p0 * sn[r].x) * qs, (y1 * cs[r].y + p1 * sn[r].y) * qs); } }
}
__device__ __forceinline__ void normrope_phase(const Args& a, const Ctx& F, int j) {
    PHASE_IDS;
    unsigned* qkv = (unsigned*)(KARG(ws) + WS_BIG); const float* ct = (const float*)(KARG(ws) + WS_ROPE); const float* st = ct + 2048;
    const f32x2 gq = *(const f32x2*)(KARG(attn_q_g) + j * 128 + 2 * lane_), gk = *(const f32x2*)(KARG(attn_k_g) + j * 128 + 2 * lane_);
    int row = gw_;
    for (; row + 3 * F.NGW < M; row += 4 * F.NGW) normrope_rows<4>(row, F.NGW, lane_, qkv, ct, st, gq, gk);
    for (; row < M; row += F.NGW) normrope_rows<1>(row, F.NGW, lane_, qkv, ct, st, gq, gk);
}

__device__ __forceinline__ void attn_phase(const Args& a, const Ctx& F, char* shm, bool ctx_units, int jm) {
    const att::bf16* qkv = (const att::bf16*)(KARG(ws) + WS_BIG); att::bf16* O = (att::bf16*)(KARG(ws) + WS_XB);
    float mraw;
    { PHASE_IDS; const f32x2 gq = *(const f32x2*)(KARG(attn_q_g) + jm * 128 + 2 * lane_), gk = *(const f32x2*)(KARG(attn_k_g) + jm * 128 + 2 * lane_);
      float mq = fmaxf(fabsf(gq.x), fabsf(gq.y)), mk = fmaxf(fabsf(gk.x), fabsf(gk.y));
#pragma unroll
      for (int o_ = 1; o_ < 64; o_ <<= 1) { mq = fmaxf(mq, __shfl_xor(mq, o_)); mk = fmaxf(mk, __shfl_xor(mk, o_)); }
      mraw = 128.0f * mq * mk * 1.0005f; }
    const int c = blockIdx.x;
    for (int i = 0;; ++i) {
        int b, h, qb; bool cu = false;
        if (F.G == 256) {
            if (i < 4) { const int p = 2 * (c & 7) + (i >> 1), w = (i & 1) * 32 + (c >> 3); b = p >> 1; h = (p & 1) * 4 + (w >> 4); qb = w & 15; }
            else if (i == 4 && c < 64 && ctx_units) { cu = true; b = c >> 3; h = c & 7; qb = 0; }
            else break;
        } else {
            const int L = i * F.G + c;
            if (L < 1024) { b = L >> 7; h = (L >> 4) & 7; qb = L & 15; }
            else if (L < 1088 && ctx_units) { cu = true; b = (L - 1024) >> 3; h = L & 7; qb = 0; }
            else break;
        }
        const size_t rowb = (size_t)b * TPB, qrow = cu ? rowb : rowb + CTX + (size_t)qb * 256; const int kvh = h >> 2;
        __syncthreads();
        att::attn_dense_body<att::bf16>(qkv + qrow * NQKV + h * 128, qkv + rowb * NQKV + 1024 + kvh * 128, qkv + rowb * NQKV + 1280 + kvh * 128, O + qrow * DM + h * 128, cu ? CTX : TPB, shm, mraw);
    }
    __syncthreads();
}

__global__ void __launch_bounds__(NTHREADS, 2) fwd_megakernel(Args a) {
    extern __shared__ __attribute__((aligned(16))) unsigned char lds[];
    cg::grid_group grid = cg::this_grid();
    Ctx F;
    F.lds = (LAS unsigned char*)lds; F.G = gridDim.x; F.NGW = F.G * NWAVES; F.NT = F.G * NTHREADS;
#define mod ((const float*)(KARG(ws) + WS_MOD))
#define XN ((bf16*)(KARG(ws) + WS_XN))
#define BIG ((bf16*)(KARG(ws) + WS_BIG))
#define XRES ((float*)(KARG(ws) + WS_XRES))

    if (threadIdx.x < 64) ((LAS unsigned*)(lds + 131072))[threadIdx.x] = 0u;
    __syncthreads();
    (void)xcd_barrier_post((unsigned*)(KARG(ws) + WS_BAR), (volatile LAS unsigned*)(lds + 131072));
#define GSYNC() do { XcdBarrier b_; b_.bar = (unsigned*)(KARG(ws) + WS_BAR); b_.x = (unsigned)__builtin_amdgcn_readfirstlane((int)xb_xcc_id()); b_.st = (volatile LAS unsigned*)(lds + 131072); xcd_barrier(b_); } while (0)
    { PHASE_IDS; float* rss = (float*)(KARG(ws) + WS_RSS); for (int e = gt_; e < 12 * M / 4; e += F.NT) ((f32x4*)rss)[e] = (f32x4){0.f, 0.f, 0.f, 0.f}; }
    p0_weights(a, F);
    p0_ada_partial(a, F);
    p0_rope_table(F);
    grid.sync();
    p1_ada_reduce(a, F);
    GSYNC();
    prep_phase(a, F);
    bias_phase(a, F);
    GSYNC();

    for (int layer = 0; layer < 4; ++layer) {
        const bool is_attn = (layer & 1) != 0; const int jm = layer >> 1;
        for (int sub = 0; sub < 3; ++sub) {
            const int sl = layer * 3 + sub;
            const float* rss = (const float*)(KARG(ws) + WS_RSS) + (size_t)sl * M; const float* sw = (const float*)(KARG(ws) + WS_SW) + (size_t)sl * 9 * NFF2;
            const float* gate = mod + layer * NMOD + (sub * 3 + 2) * 1024;
            const bf16* A2; const bf16* B2; int K2; float coef;
            if (sub != 1) {
                const int fi = layer * 2 + (sub >> 1);
                { pg8::Gemm g{XN, (const bf16*)(KARG(ws) + WS_WFI) + (size_t)fi * NFF2 * DM, M, NFF2, DM}; pg8::StaticOrder S; S.init(M, NFF2, DM, F.G, (int)blockIdx.x, (layer == 3 && sub == 2) ? 1 : 0);
                  pg8::EpiSwiglu E{BIG, FF, rss, sw};
                  pg8::gemm_phase<pg8::EpiSwiglu, pg8::StaticOrder, true, true>(F.lds, g, S, E); }
                GSYNC();
                A2 = BIG; B2 = (const bf16*)(KARG(ws) + WS_WFO) + (size_t)fi * DM * FF; K2 = FF; coef = 0.5f;
            } else {
                const int N1 = is_attn ? NQKV : NCONV;
                { pg8::Gemm g{XN, is_attn ? (const bf16*)(KARG(ws) + WS_WQKV) + (size_t)jm * NQKV * DM : (const bf16*)(KARG(ws) + WS_WCI) + (size_t)jm * NCONV * DM, M, N1, DM};
                  pg8::TailOrder S; S.init(M, N1, DM, F.G, (int)blockIdx.x);
                  if (is_attn) { pg8::EpiBf16N E{BIG, N1, rss, sw}; pg8::gemm_phase<pg8::EpiBf16N, pg8::TailOrder, true, true>(F.lds, g, S, E); }
                  else { pg8::EpiConvIn E{BIG, rss, sw}; pg8::gemm_phase<pg8::EpiConvIn, pg8::TailOrder, true, true>(F.lds, g, S, E); } }
                GSYNC();
                if (is_attn) { normrope_phase(a, F, jm); GSYNC(); attn_phase(a, F, (char*)lds, layer != 3, jm); }
                else conv_phase(a, F, jm);
                GSYNC();
                A2 = (const bf16*)(KARG(ws) + WS_XB); B2 = is_attn ? (const bf16*)(KARG(ws) + WS_WO) + (size_t)jm * DM * DM : (const bf16*)(KARG(ws) + WS_WCO) + (size_t)jm * DM * DM; K2 = DM; coef = 1.0f;
            }
            { pg8::Gemm g{A2, B2, M, DM, K2}; pg8::TailOrder S; S.init(M, DM, K2, F.G, (int)blockIdx.x, (layer == 3 && sub >= 1) ? 1 : 0);
              const int sn = sl + 1, ln = sn / 3, subn = sn - ln * 3; const bool fold = sn < 12;
              unsigned char* wsp = KARG(ws); const int snc = fold ? sn : 0, lnc = fold ? ln : 0;
              float* e_x = (float*)(wsp + WS_XRES); bf16* e_xs = fold ? (bf16*)(wsp + WS_XN) : (bf16*)nullptr; const float* e_gn = KARG(norm_g) + (size_t)snc * 1024;
              const float* e_scn = (const float*)(wsp + WS_MOD) + lnc * NMOD + (subn * 3 + 1) * 1024; float* e_rssn = (float*)(wsp + WS_RSS) + (size_t)snc * M;
              const pg8::EpiRes E{e_x, gate, sub != 1 ? 1 : 0, e_xs, e_gn, e_scn, e_rssn};
              pg8::gemm_phase<pg8::EpiRes, pg8::TailOrder, true, true>(F.lds, g, S, E); }
            GSYNC();
        }
    }
    final_phase(a, F);
}

extern "C" void kernel_launch(void* const* d_in, const int* in_sizes, int n_in, void* d_out, int out_size, void* d_ws, size_t ws_size, hipStream_t stream) {
    static int grid = 0;
    if (grid == 0) {
        if (n_in != 17 || in_sizes[0] != NB * SEQ * DM || out_size != NB * SEQ * DM || ws_size < WS_END) {
            fprintf(stderr, "kernel_launch: shape/workspace mismatch: n_in %d in0 %d out %d ws %zu (need %zu)\n", n_in, n_in > 0 ? in_sizes[0] : -1, out_size, ws_size, (size_t)WS_END); grid = -1; return; }
        int dev = 0, cus = 0, per_cu = 0;
        if (hipGetDevice(&dev) != hipSuccess || hipDeviceGetAttribute(&cus, hipDeviceAttributeMultiprocessorCount, dev) != hipSuccess) { fprintf(stderr, "kernel_launch: device query failed\n"); grid = -1; return; }
        if (hipFuncSetAttribute((const void*)fwd_megakernel, hipFuncAttributeMaxDynamicSharedMemorySize, LDS_BYTES) != hipSuccess) { fprintf(stderr, "kernel_launch: hipFuncSetAttribute failed\n"); grid = -1; return; }
        if (hipOccupancyMaxActiveBlocksPerMultiprocessor(&per_cu, (const void*)fwd_megakernel, NTHREADS, LDS_BYTES) != hipSuccess || per_cu < 1) { fprintf(stderr, "kernel_launch: occupancy query gave %d\n", per_cu); (void)hipGetLastError(); per_cu = 1; }
        grid = cus * per_cu;
    }
    if (grid < 0) return;
    if (hipMemsetAsync((char*)d_ws + WS_BAR, 0, BAR_BYTES, stream) != hipSuccess) { fprintf(stderr, "kernel_launch: hipMemsetAsync failed\n"); return; }
    Args a{};
    a.x = (const float*)d_in[0]; a.c = (const float*)d_in[1]; a.ctx = (const float*)d_in[2]; a.c_ctx = (const float*)d_in[3]; a.ada_w = (const float*)d_in[4]; a.ada_b = (const float*)d_in[5];
    a.norm_g = (const float*)d_in[6]; a.final_g = (const float*)d_in[7]; a.ffn_w_in = (const float*)d_in[8]; a.ffn_w_out = (const float*)d_in[9]; a.conv_w_in = (const float*)d_in[10]; a.conv_w = (const float*)d_in[11];
    a.conv_w_out = (const float*)d_in[12]; a.attn_w_qkv = (const float*)d_in[13]; a.attn_q_g = (const float*)d_in[14]; a.attn_k_g = (const float*)d_in[15]; a.attn_w_o = (const float*)d_in[16];
    a.out = (float*)d_out; a.ws = (unsigned char*)d_ws;
    void* args[] = {&a};
    const hipError_t e = hipLaunchCooperativeKernel((const void*)fwd_megakernel, dim3(grid), dim3(NTHREADS), args, LDS_BYTES, stream);
    if (e != hipSuccess) fprintf(stderr, "kernel_launch: cooperative launch failed: %s (grid %d)\n", hipGetErrorString(e), grid);
}
```

```cpp
#include <hip/hip_runtime.h>
#include <hip/hip_bf16.h>
#include <hip/hip_cooperative_groups.h>
#include <cstdio>
#include <cstdint>
#include <cstddef>
#include <cmath>
namespace cg = cooperative_groups;
__device__ __forceinline__ int opaque_tid() { int t = threadIdx.x; asm volatile("" : "+v"(t)); return t; }
namespace pg8 {
#define PG8_LAS __attribute__((address_space(3)))
typedef unsigned short bf16_t;
typedef short bf16x8 __attribute__((ext_vector_type(8)));
typedef float f32x4 __attribute__((ext_vector_type(4)));
typedef unsigned u32x4 __attribute__((ext_vector_type(4)));
typedef unsigned u32x2 __attribute__((ext_vector_type(2)));
constexpr int BM = 256, BK = 64, HALF = 128, HTB = HALF * BK * 2  , STAGE_BYTES = 8 * HTB, NXCD = 8, WGM = 8;

__host__ __device__ __forceinline__ int lds_byte(int r, int c) { const int st = (r >> 4) * 2 + (c >> 5), rr = r & 15, cc = c & 31, ob = rr * 64 + cc * 2; return st * 1024 + (ob ^ (((ob >> 9) & 1) << 5)); }
__host__ __device__ __forceinline__ void stage_rc(int b, int& R, int& C) { const int st = b / 1024, sb = b % 1024, swz = sb ^ (((sb >> 9) & 1) << 5); R = (st >> 1) * 16 + swz / 64; C = (st & 1) * 32 + (swz % 64) / 2; }
__host__ __device__ __forceinline__ int perm32(int rho) { const int n = rho >> 4, i = rho & 15; return 8 * (i >> 2) + 4 * n + (i & 3); }

struct Unit { int pm, pn, kt0, nkt, sliced, ha, hb; };
struct Gemm { const bf16_t* A; const bf16_t* Bt; int M, N, K; };

struct StaticOrder {
    int nM, nN, nwg, G, c, nkt, lat;
    __host__ __device__ void init(int M, int N, int K, int G_, int c_, int lat_ = 0) { lat = lat_; nM = lat ? 128 : M / BM; nN = N / BM; nwg = nM * nN; G = G_; c = c_; nkt = K / BK; }
    __host__ __device__ bool next(int i, Unit& u) const {
        const long L = (long)i * G + c; if (L >= nwg) return false;
        u.kt0 = 0; u.nkt = nkt; u.sliced = 0; u.ha = -1; u.hb = -1;
        int wgid = (int)L; { const int q = nwg / NXCD, r = nwg % NXCD, xcd = wgid % NXCD, off = wgid / NXCD; wgid = (xcd < r ? xcd * (q + 1) : r * (q + 1) + (xcd - r) * q) + off; }
        const int nig = WGM * nN, gid = wgid / nig, fm = gid * WGM, gsz = (nM - fm) < WGM ? (nM - fm) : WGM;
        u.pm = fm + ((wgid % nig) % gsz); u.pn = (wgid % nig) / gsz; if (lat) u.pm += (u.pm >> 4) + 1; return true;
    }
    __device__ __forceinline__ void a_ready(const Unit&) const {}
    __device__ __forceinline__ void done(const Unit&) const {}
};
struct TailOrder {
    int nM, nN, nwg, G, c, nkt, rounds, left, mode, lat;
    __host__ __device__ void init(int M, int N, int K, int G_, int c_, int lat_ = 0) { lat = lat_; nM = lat ? 128 : M / BM; nN = N / BM; nwg = nM * nN; G = G_; c = c_; nkt = K / BK; rounds = nwg / G; left = nwg - rounds * G; mode = 0;
        if (left > 0) { if (left * 4 <= G) mode = 4; else if (left * 2 <= G) mode = 2; } }
    __host__ __device__ void tile(int wgid, Unit& u) const {
        { const int q = nwg / NXCD, r = nwg % NXCD, xcd = wgid % NXCD, off = wgid / NXCD; wgid = (xcd < r ? xcd * (q + 1) : r * (q + 1) + (xcd - r) * q) + off; }
        const int nig = WGM * nN, gid = wgid / nig, fm = gid * WGM, gsz = (nM - fm) < WGM ? (nM - fm) : WGM;
        u.pm = fm + ((wgid % nig) % gsz); u.pn = (wgid % nig) / gsz; if (lat) u.pm += (u.pm >> 4) + 1; }
    __host__ __device__ bool next(int i, Unit& u) const {
        u.kt0 = 0; u.nkt = nkt; u.sliced = 0; u.ha = -1; u.hb = -1;
        if (mode == 0 || i < rounds) { const long L = (long)i * G + c; if (L >= nwg) return false; tile((int)L, u); return true; }
        if (i > rounds || c >= left * mode) return false;
        int t, piece;
        if ((left & 7) == 0) { const int q = c >> 3, x = c & 7; t = x + 8 * (q / mode); piece = q % mode; } else { t = c / mode; piece = c % mode; }
        tile(rounds * G + t, u); u.ha = piece & 1; u.hb = (mode == 4) ? (piece >> 1) : -1; return true;
    }
    __device__ __forceinline__ void a_ready(const Unit&) const {}
    __device__ __forceinline__ void done(const Unit&) const {}
};
struct SlicedOrder {
    int nM, nN, nwg, G, c, nkt, rounds, left, ns;
    __host__ __device__ void init(int M, int N, int K, int G_, int c_) { nM = M / BM; nN = N / BM; nwg = nM * nN; G = G_; c = c_; nkt = K / BK; rounds = nwg / G; left = nwg - rounds * G; ns = 0;
        if (left > 0 && G % left == 0 && (nkt / 2) >= G / left) ns = G / left; }
    __host__ __device__ void tile(int wgid, Unit& u) const {
        { const int q = nwg / NXCD, r = nwg % NXCD, xcd = wgid % NXCD, off = wgid / NXCD; wgid = (xcd < r ? xcd * (q + 1) : r * (q + 1) + (xcd - r) * q) + off; }
        const int nig = WGM * nN, gid = wgid / nig, fm = gid * WGM, gsz = (nM - fm) < WGM ? (nM - fm) : WGM;
        u.pm = fm + ((wgid % nig) % gsz); u.pn = (wgid % nig) / gsz; }
    __host__ __device__ bool next(int i, Unit& u) const {
        if (ns == 0 || i < rounds) { const long L = (long)i * G + c; if (L >= nwg) return false; tile((int)L, u); u.kt0 = 0; u.nkt = nkt; u.sliced = 0; u.ha = -1; u.hb = -1; return true; }
        if (i > rounds) return false;
        const int sl = c / left, pairs = nkt / 2, base = pairs / ns, rem = pairs % ns;
        tile(rounds * G + c % left, u); u.kt0 = 2 * (sl * base + (sl < rem ? sl : rem)); u.nkt = 2 * (base + (sl < rem ? 1 : 0)); u.sliced = 1; u.ha = -1; u.hb = -1; return true;
    }
    __device__ __forceinline__ void a_ready(const Unit&) const {}
    __device__ __forceinline__ void done(const Unit&) const {}
};

__device__ __forceinline__ unsigned cvt_pk_bf16(float lo, float hi) { unsigned r; asm volatile("v_cvt_pk_bf16_f32 %0, %1, %2" : "=v"(r) : "v"(lo), "v"(hi)); return r; }
typedef float f32x2 __attribute__((ext_vector_type(2)));
__device__ __forceinline__ f32x2 gelu_pk(f32x2 v) {
    const f32x2 av = __builtin_elementwise_abs(v), d = av * 0.2316418882f + 1.0f;
    f32x2 t; t.x = __builtin_amdgcn_rcpf(d.x); t.y = __builtin_amdgcn_rcpf(d.y);
    f32x2 q = t * 0.5307027145f + (-0.7265760135f); q = q * t + 0.7107068705f; q = q * t + (-0.142248368f); q = q * t + 0.127414796f; q = q * t;
    const f32x2 s = (v * v) * (-0.72134752044f);
    f32x2 e; e.x = __builtin_amdgcn_exp2f(s.x); e.y = __builtin_amdgcn_exp2f(s.y);
    const f32x2 m = v * (q * e), r = v - m;
    f32x2 o; o.x = v.x < 0.f ? m.x : r.x; o.y = v.y < 0.f ? m.y : r.y; return o;
}

template <int ACT  > struct EpiBf16 {
    static constexpr bool PERM = true, AFTER_DRAIN = false; static_assert(ACT == 0 || ACT == 1, "EpiBf16: ACT is 0 (none) or 1 (gelu_pk)");
    bf16_t* O; int ldc; const float* bias; int split_cols; size_t split_stride; float scale0;
    __device__ __forceinline__ void operator()(const f32x4 (&acc)[2][2][4][2], const Unit& u, int wr, int wc, int fr, int fq) const {
        const int row0 = u.pm * BM + wr * 64 + fr; int colt = u.pn * BM; bf16_t* base = O;
        float sc = 1.f; if (split_cols) { const int t = colt / split_cols; base += (size_t)t * split_stride; colt -= t * split_cols; if (t == 0) sc = scale0; }
        const int col0 = colt + wc * 32 + 8 * fq, bcol0 = u.pn * BM + wc * 32 + 8 * fq;
        f32x4 bv[2][2];
#pragma unroll
        for (int bj = 0; bj < 2; ++bj)
#pragma unroll
            for (int n = 0; n < 2; ++n) bv[bj][n] = bias ? *(const f32x4*)(bias + bcol0 + bj * HALF + 4 * n) : (f32x4){0.f, 0.f, 0.f, 0.f};
#pragma unroll
        for (int ai = 0; ai < 2; ++ai)
#pragma unroll
            for (int m = 0; m < 4; ++m) { bf16_t* rowp = base + (size_t)(row0 + ai * HALF + m * 16) * ldc + col0;
#pragma unroll
                for (int bj = 0; bj < 2; ++bj) { f32x4 v0 = acc[ai][bj][m][0] + bv[bj][0], v1 = acc[ai][bj][m][1] + bv[bj][1];
                    if (ACT == 1) { f32x2 a = gelu_pk((f32x2){v0[0], v0[1]}), b = gelu_pk((f32x2){v0[2], v0[3]}), c = gelu_pk((f32x2){v1[0], v1[1]}), d = gelu_pk((f32x2){v1[2], v1[3]});
                        v0 = (f32x4){a.x, a.y, b.x, b.y}; v1 = (f32x4){c.x, c.y, d.x, d.y}; }
                    v0 = v0 * sc; v1 = v1 * sc; u32x4 w; w.x = cvt_pk_bf16(v0[0], v0[1]); w.y = cvt_pk_bf16(v0[2], v0[3]); w.z = cvt_pk_bf16(v1[0], v1[1]); w.w = cvt_pk_bf16(v1[2], v1[3]);
                    *(u32x4*)(rowp + bj * HALF) = w; } }
    }
};
__device__ __forceinline__ int mod_index(int pm) { const int b = pm / 17; return (pm - b * 17 == 0) ? 8 : b; }
__device__ __forceinline__ f32x2 swiglu_pk(f32x2 g, f32x2 u) {
    const f32x2 t = g * (-1.4426950408889634f); f32x2 e; e.x = __builtin_amdgcn_exp2f(t.x); e.y = __builtin_amdgcn_exp2f(t.y);
    const f32x2 d = e + 1.0f; f32x2 r; r.x = __builtin_amdgcn_rcpf(d.x); r.y = __builtin_amdgcn_rcpf(d.y);
    return (g * u) * r; }
__device__ __forceinline__ float silu_f(float g) { return g * __builtin_amdgcn_rcpf(1.0f + __builtin_amdgcn_exp2f(-1.4426950408889634f * g)); }
__device__ __forceinline__ float rstd_of(const float* rss, int row) { return 1.0f / sqrtf(rss[row] * (1.0f / 1024.0f) + 1e-6f); }
struct EpiSwiglu {
    static constexpr bool PERM = true, AFTER_DRAIN = false;
    bf16_t* O; int ldc; const float* rss; const float* sw;
    struct Pf { float r[2][4]; f32x4 bg0, bg1, bu0, bu1; };
    __device__ __forceinline__ Pf prefetch(const Unit& u, int wr, int fr) const { Pf p; const int row0 = u.pm * BM + wr * 64 + fr;
        const int lane = threadIdx.x & 63, wc = (threadIdx.x >> 6) & 3, fq = lane >> 4;
#pragma unroll
        for (int ai = 0; ai < 2; ++ai)
#pragma unroll
            for (int m = 0; m < 4; ++m) p.r[ai][m] = rss[row0 + ai * HALF + m * 16];
        const float* bp = sw + (size_t)mod_index(u.pm) * 5632 + u.pn * BM + wc * 32 + 8 * fq;
        p.bg0 = *(const f32x4*)bp; p.bg1 = *(const f32x4*)(bp + 4); p.bu0 = *(const f32x4*)(bp + HALF); p.bu1 = *(const f32x4*)(bp + HALF + 4);
        return p; }
    __device__ __forceinline__ void operator()(const f32x4 (&acc)[2][2][4][2], const Unit& u, int wr, int wc, int fr, int fq, const Pf& pf) const {
        const int row0 = u.pm * BM + wr * 64 + fr, col0 = u.pn * HALF + wc * 32 + 8 * fq;
        const f32x4 bg0 = pf.bg0, bg1 = pf.bg1, bu0 = pf.bu0, bu1 = pf.bu1;
#pragma unroll
        for (int ai = 0; ai < 2; ++ai)
#pragma unroll
            for (int m = 0; m < 4; ++m) { const int row = row0 + ai * HALF + m * 16; bf16_t* rowp = O + (size_t)row * ldc + col0; const float rs = __builtin_amdgcn_rsqf(pf.r[ai][m] * (1.0f / 1024.0f) + 1e-6f);
                const f32x4 g0 = acc[ai][0][m][0] * rs + bg0, g1 = acc[ai][0][m][1] * rs + bg1, u0 = acc[ai][1][m][0] * rs + bu0, u1 = acc[ai][1][m][1] * rs + bu1;
                const f32x2 ha = swiglu_pk((f32x2){g0[0], g0[1]}, (f32x2){u0[0], u0[1]}), hb = swiglu_pk((f32x2){g0[2], g0[3]}, (f32x2){u0[2], u0[3]});
                const f32x2 hc = swiglu_pk((f32x2){g1[0], g1[1]}, (f32x2){u1[0], u1[1]}), hd = swiglu_pk((f32x2){g1[2], g1[3]}, (f32x2){u1[2], u1[3]});
                u32x4 w; w.x = cvt_pk_bf16(ha.x, ha.y); w.y = cvt_pk_bf16(hb.x, hb.y); w.z = cvt_pk_bf16(hc.x, hc.y); w.w = cvt_pk_bf16(hd.x, hd.y);
                *(u32x4*)rowp = w; }
    }
};
struct EpiBf16N {
    static constexpr bool PERM = true, AFTER_DRAIN = false;
    bf16_t* O; int ldc; const float* rss; const float* sw;
    struct Pf { float r[2][4]; };
    __device__ __forceinline__ Pf prefetch(const Unit& u, int wr, int fr) const { Pf p; const int row0 = u.pm * BM + (u.ha > 0 ? HALF : 0) + wr * 64 + fr;
#pragma unroll
        for (int ai = 0; ai < 2; ++ai)
#pragma unroll
            for (int m = 0; m < 4; ++m) p.r[ai][m] = rss[row0 + ai * HALF + m * 16];
        return p; }
    __device__ __forceinline__ void operator()(const f32x4 (&acc)[2][2][4][2], const Unit& u, int wr, int wc, int fr, int fq, const Pf& pf) const {
        const int row0 = u.pm * BM + (u.ha > 0 ? HALF : 0) + wr * 64 + fr, col0 = u.pn * BM + (u.hb > 0 ? HALF : 0) + wc * 32 + 8 * fq; const int na = u.ha < 0 ? 2 : 1, nb = u.hb < 0 ? 2 : 1;
        const float* bp = sw + (size_t)mod_index(u.pm) * 5632 + col0;
        f32x4 bv[2][2];
#pragma unroll
        for (int bj = 0; bj < 2; ++bj)
#pragma unroll
            for (int n = 0; n < 2; ++n) bv[bj][n] = *(const f32x4*)(bp + bj * HALF + 4 * n);
#pragma unroll
        for (int ai = 0; ai < 2; ++ai) if (ai < na)
#pragma unroll
            for (int m = 0; m < 4; ++m) { const int row = row0 + ai * HALF + m * 16; bf16_t* rowp = O + (size_t)row * ldc + col0; const float rs = __builtin_amdgcn_rsqf(pf.r[ai][m] * (1.0f / 1024.0f) + 1e-6f);
#pragma unroll
                for (int bj = 0; bj < 2; ++bj) if (bj < nb) { const f32x4 v0 = acc[ai][bj][m][0] * rs + bv[bj][0], v1 = acc[ai][bj][m][1] * rs + bv[bj][1];
                    u32x4 w; w.x = cvt_pk_bf16(v0[0], v0[1]); w.y = cvt_pk_bf16(v0[2], v0[3]); w.z = cvt_pk_bf16(v1[0], v1[1]); w.w = cvt_pk_bf16(v1[2], v1[3]);
                    *(u32x4*)(rowp + bj * HALF) = w; } }
    }
};
struct EpiConvIn {
    static constexpr bool PERM = true, AFTER_DRAIN = false;
    bf16_t* O; const float* rss; const float* sw;
    struct Pf { float r[2][4]; };
    __device__ __forceinline__ Pf prefetch(const Unit& u, int wr, int fr) const { Pf p; const int row0 = u.pm * BM + (u.ha > 0 ? HALF : 0) + wr * 64 + fr;
#pragma unroll
        for (int ai = 0; ai < 2; ++ai)
#pragma unroll
            for (int m = 0; m < 4; ++m) p.r[ai][m] = rss[row0 + ai * HALF + m * 16];
        return p; }
    __device__ __forceinline__ void operator()(const f32x4 (&acc)[2][2][4][2], const Unit& u, int wr, int wc, int fr, int fq, const Pf& pf) const {
        const int row0 = u.pm * BM + (u.ha > 0 ? HALF : 0) + wr * 64 + fr; const int na = u.ha < 0 ? 2 : 1;
        const float* bp = sw + (size_t)mod_index(u.pm) * 5632 + u.pn * BM + wc * 32 + 8 * fq;
        f32x4 bv[2][2];
#pragma unroll
        for (int bj = 0; bj < 2; ++bj)
#pragma unroll
            for (int n = 0; n < 2; ++n) bv[bj][n] = *(const f32x4*)(bp + bj * HALF + 4 * n);
        const bool paired = u.pn >= 4;
        const int col0 = paired ? 1024 + (u.pn - 4) * HALF + wc * 32 + 8 * fq : u.pn * BM + wc * 32 + 8 * fq;
#pragma unroll
        for (int ai = 0; ai < 2; ++ai) if (ai < na)
#pragma unroll
            for (int m = 0; m < 4; ++m) { const int row = row0 + ai * HALF + m * 16; bf16_t* rowp = O + (size_t)row * 2048 + col0; const float rs = __builtin_amdgcn_rsqf(pf.r[ai][m] * (1.0f / 1024.0f) + 1e-6f);
                const f32x4 a0 = acc[ai][0][m][0] * rs + bv[0][0], a1 = acc[ai][0][m][1] * rs + bv[0][1], c0 = acc[ai][1][m][0] * rs + bv[1][0], c1 = acc[ai][1][m][1] * rs + bv[1][1];
                if (paired) { const f32x4 p0 = a0 * c0, p1 = a1 * c1;
                    u32x4 w; w.x = cvt_pk_bf16(p0[0], p0[1]); w.y = cvt_pk_bf16(p0[2], p0[3]); w.z = cvt_pk_bf16(p1[0], p1[1]); w.w = cvt_pk_bf16(p1[2], p1[3]);
                    *(u32x4*)rowp = w; }
                else { u32x4 w; w.x = cvt_pk_bf16(a0[0], a0[1]); w.y = cvt_pk_bf16(a0[2], a0[3]); w.z = cvt_pk_bf16(a1[0], a1[1]); w.w = cvt_pk_bf16(a1[2], a1[3]);
                    *(u32x4*)rowp = w;
                    u32x4 w2; w2.x = cvt_pk_bf16(c0[0], c0[1]); w2.y = cvt_pk_bf16(c0[2], c0[3]); w2.z = cvt_pk_bf16(c1[0], c1[1]); w2.w = cvt_pk_bf16(c1[2], c1[3]);
                    *(u32x4*)(rowp + HALF) = w2; } }
    }
};
struct EpiRes {
    static constexpr bool PERM = true, AFTER_DRAIN = false;
    float* X; const float* gate; int halfstep; bf16_t* xs; const float* gn; const float* scn; float* rssn;
    struct Pf {};
    __device__ __forceinline__ Pf prefetch(const Unit&, int, int) const { return Pf{}; }
    template <int NA, int NB, bool FOLD>
    __device__ __forceinline__ void body(const f32x4 (&acc)[2][2][4][2], const Unit& u, int wr, int wc, int fr, int fq) const {
        const int mi = mod_index(u.pm); const float coef = halfstep ? 0.5f : 1.0f;
        const float* gv = gate + (size_t)mi * 36864;
        const int col0 = u.pn * BM + wc * 32 + 8 * fq + (u.hb > 0 ? HALF : 0); const int rofs = u.ha > 0 ? HALF : 0;
        f32x4 gg[NB][2], gs[NB][2];
#pragma unroll
        for (int bj = 0; bj < NB; ++bj)
#pragma unroll
            for (int n = 0; n < 2; ++n) { gg[bj][n] = *(const f32x4*)(gv + col0 + bj * HALF + n * 4) * coef;
                if (FOLD) gs[bj][n] = *(const f32x4*)(gn + col0 + bj * HALF + n * 4) * (*(const f32x4*)(scn + (size_t)mi * 36864 + col0 + bj * HALF + n * 4) + 1.0f); }
#pragma unroll
        for (int ai = 0; ai < NA; ++ai) {
#pragma unroll
          for (int mh = 0; mh < 2; ++mh) {
            f32x4 pre[2][NB][2];
#pragma unroll
            for (int mm = 0; mm < 2; ++mm) { const int m = mh * 2 + mm; const float* xp = X + (size_t)(u.pm * BM + rofs + ai * HALF + wr * 64 + m * 16 + fr) * 1024 + col0;
#pragma unroll
                for (int bj = 0; bj < NB; ++bj)
#pragma unroll
                    for (int n = 0; n < 2; ++n) pre[mm][bj][n] = __builtin_nontemporal_load((const f32x4*)(xp + bj * HALF + n * 4)); }
            asm volatile("" ::: "memory");
#pragma unroll
            for (int mm = 0; mm < 2; ++mm) { const int m = mh * 2 + mm; const int row = u.pm * BM + rofs + ai * HALF + wr * 64 + m * 16 + fr; float* xp = X + (size_t)row * 1024 + col0; float ss = 0.f;
#pragma unroll
                for (int bj = 0; bj < NB; ++bj) { float* p = xp + bj * HALF;
                    const f32x4 x0 = pre[mm][bj][0] + gg[bj][0] * acc[ai][bj][m][0], x1 = pre[mm][bj][1] + gg[bj][1] * acc[ai][bj][m][1];
                    __builtin_nontemporal_store(x0, (f32x4*)p); __builtin_nontemporal_store(x1, (f32x4*)(p + 4));
                    if (FOLD) { const f32x4 q = x0 * x0 + x1 * x1; ss += (q[0] + q[1]) + (q[2] + q[3]);
                        const f32x4 o0 = x0 * gs[bj][0], o1 = x1 * gs[bj][1];
                        u32x4 w; w.x = cvt_pk_bf16(o0[0], o0[1]); w.y = cvt_pk_bf16(o0[2], o0[3]); w.z = cvt_pk_bf16(o1[0], o1[1]); w.w = cvt_pk_bf16(o1[2], o1[3]);
                        *(u32x4*)(xs + (size_t)row * 1024 + col0 + bj * HALF) = w; } }
                if (FOLD) { ss += __shfl_xor(ss, 16); ss += __shfl_xor(ss, 32); if (fq == 0) unsafeAtomicAdd(rssn + row, ss); } }
            asm volatile("" ::: "memory"); } }
    }
    __device__ __forceinline__ void operator()(const f32x4 (&acc)[2][2][4][2], const Unit& u, int wr, int wc, int fr, int fq, const Pf&) const {
        const bool fold = xs != nullptr;
        if (u.ha < 0 && u.hb < 0) { if (fold) body<2, 2, true>(acc, u, wr, wc, fr, fq); else body<2, 2, false>(acc, u, wr, wc, fr, fq); }
        else if (u.hb < 0) { if (fold) body<1, 2, true>(acc, u, wr, wc, fr, fq); else body<1, 2, false>(acc, u, wr, wc, fr, fq); }
        else { if (fold) body<1, 1, true>(acc, u, wr, wc, fr, fq); else body<1, 1, false>(acc, u, wr, wc, fr, fq); }
    }
};

template <class Epi, class Sched, bool ALIGN_EPI = false, bool SP2 = false>
__device__ __forceinline__ void gemm_phase(PG8_LAS unsigned char* lds, const Gemm g, const Sched& S, const Epi& E) {
    const int tid = opaque_tid(), wid = __builtin_amdgcn_readfirstlane(tid >> 6), lane = tid & 63, wr = wid >> 2, wc = wid & 3, fr = lane & 15, fq = lane >> 4;
    const int K = g.K;
    unsigned voffA[2], voffB[2];
#pragma unroll
    for (int i = 0; i < 2; ++i) { int R, C; stage_rc(tid * 16 + i * 8192, R, C); const int Rb = Epi::PERM ? ((R & ~31) + perm32(R & 31)) : R;
        voffA[i] = (unsigned)(R * K + C) * 2u; voffB[i] = (unsigned)(Rb * K + C) * 2u; }
    const size_t kstep = (size_t)(BK * 2);
    const size_t hstep = (size_t)HALF * K * 2;
    const size_t tstep = 2 * hstep;
    const unsigned ldsw = (unsigned)wid * 1024u;
    const int aoff = lds_byte(wr * 64 + fr, fq * 8), boff = lds_byte(wc * 32 + fr, fq * 8);
#define PG8_SA(b, h) (((b) * 2 + (h)) * HTB)
#define PG8_SB(b, h) ((4 + (b) * 2 + (h)) * HTB)
#define PG8_STAGE(bufoff, gbase, voff) do { _Pragma("unroll") for (int _i = 0; _i < 2; ++_i) \
        __builtin_amdgcn_global_load_lds((const unsigned*)((const char*)(gbase) + (voff)[_i]), (PG8_LAS unsigned*)(lds + (bufoff) + ldsw + _i * 8192), 16, 0, 0); } while (0)
#define PG8_LDA(dst, b, h) do { _Pragma("unroll") for (int m = 0; m < 4; ++m) _Pragma("unroll") for (int k = 0; k < 2; ++k) dst[m][k] = *(const PG8_LAS bf16x8*)(lds + PG8_SA(b, h) + aoff + m * 2048 + k * 1024); } while (0)
#define PG8_LDB(dst, b, h) do { _Pragma("unroll") for (int n = 0; n < 2; ++n) _Pragma("unroll") for (int k = 0; k < 2; ++k) dst[n][k] = *(const PG8_LAS bf16x8*)(lds + PG8_SB(b, h) + boff + n * 2048 + k * 1024); } while (0)
#define PG8_MMA(ai, bj, At, Bt) do { __builtin_amdgcn_s_setprio(1); _Pragma("unroll") for (int m = 0; m < 4; ++m) _Pragma("unroll") for (int n = 0; n < 2; ++n) _Pragma("unroll") for (int k = 0; k < 2; ++k) \
        acc[ai][bj][m][n] = __builtin_amdgcn_mfma_f32_16x16x32_bf16(Bt[n][k], At[m][k], acc[ai][bj][m][n], 0, 0, 0); __builtin_amdgcn_s_setprio(0); } while (0)
#define PG8_WAIT_V(n) asm volatile("s_waitcnt vmcnt(" #n ")" ::: "memory")
#define PG8_WAIT_L(n) asm volatile("s_waitcnt lgkmcnt(" #n ")" ::: "memory")
#define PG8_BAR __builtin_amdgcn_s_barrier()
#define PG8_SCHED __builtin_amdgcn_sched_barrier(0)
    Unit cur, nxt; int ui = 0;
    if (!S.next(0, cur)) return;
    f32x4 acc[2][2][4][2];
#pragma unroll
    for (int a = 0; a < 2; ++a)
#pragma unroll
        for (int b = 0; b < 2; ++b)
#pragma unroll
            for (int m = 0; m < 4; ++m)
#pragma unroll
                for (int n = 0; n < 2; ++n) acc[a][b][m][n] = (f32x4){0.f, 0.f, 0.f, 0.f};
    bf16x8 At[4][2], B0[2][2], B1[2][2];
    const char* cA = (const char*)g.A + (size_t)cur.pm * tstep + (size_t)cur.kt0 * kstep + (cur.ha > 0 ? hstep : (size_t)0); const char* cB = (const char*)g.Bt + (size_t)cur.pn * tstep + (size_t)cur.kt0 * kstep + (cur.hb > 0 ? hstep : (size_t)0);
    S.a_ready(cur);
    if constexpr (SP2) {
        PG8_STAGE(PG8_SB(0, 0), cB, voffB); PG8_STAGE(PG8_SB(0, 1), cB + hstep, voffB); PG8_STAGE(PG8_SA(0, 0), cA, voffA); PG8_STAGE(PG8_SA(0, 1), cA + hstep, voffA);
        if (wr == 1) PG8_BAR;
        PG8_WAIT_V(2); PG8_BAR;
        PG8_STAGE(PG8_SB(1, 0), cB + kstep, voffB); PG8_STAGE(PG8_SA(1, 0), cA + kstep, voffA); PG8_STAGE(PG8_SB(1, 1), cB + hstep + kstep, voffB);
        PG8_WAIT_V(6); PG8_BAR;
    } else {
        PG8_STAGE(PG8_SB(0, 0), cB, voffB); PG8_STAGE(PG8_SA(0, 0), cA, voffA); PG8_STAGE(PG8_SB(0, 1), cB + hstep, voffB); PG8_STAGE(PG8_SA(0, 1), cA + hstep, voffA);
        if (wr == 1) PG8_BAR;
        PG8_WAIT_V(4); PG8_BAR;
        PG8_STAGE(PG8_SB(1, 0), cB + kstep, voffB); PG8_STAGE(PG8_SA(1, 0), cA + kstep, voffA); PG8_STAGE(PG8_SB(1, 1), cB + hstep + kstep, voffB);
        PG8_WAIT_V(6); PG8_BAR;
    }
    for (;;) {
        const bool has_next = S.next(ui + 1, nxt);
        const char* nA = has_next ? (const char*)g.A + (size_t)nxt.pm * tstep + (size_t)nxt.kt0 * kstep + (nxt.ha > 0 ? hstep : (size_t)0) : cA; const char* nB = has_next ? (const char*)g.Bt + (size_t)nxt.pn * tstep + (size_t)nxt.kt0 * kstep + (nxt.hb > 0 ? hstep : (size_t)0) : cB;
        const typename Epi::Pf pf = E.prefetch(cur, wr, fr);
        const int nt = cur.nkt; const bool doA1 = cur.ha < 0, doB1 = cur.hb < 0;
        for (int t = 0; t < nt; t += 2) {
            const bool last = (t == nt - 2);
            const char* a1 = cA + (size_t)(t + 1) * kstep;
            const char* a2 = last ? nA : cA + (size_t)(t + 2) * kstep; const char* b2 = last ? nB : cB + (size_t)(t + 2) * kstep;
            const char* a3 = a2 + kstep; const char* b3 = b2 + kstep;
            if (last && has_next) S.a_ready(nxt);
            if constexpr (SP2) {
            PG8_LDB(B0, 0, 0); PG8_LDB(B1, 0, 1); PG8_SCHED; PG8_LDA(At, 0, 0); PG8_STAGE(PG8_SA(1, 1), a1 + hstep, voffA);
            PG8_WAIT_V(8); PG8_WAIT_L(0); PG8_BAR; PG8_MMA(0, 0, At, B0); if (doB1) PG8_MMA(0, 1, At, B1); PG8_BAR; PG8_SCHED;
            PG8_LDA(At, 0, 1); PG8_STAGE(PG8_SB(0, 0), b2, voffB); PG8_STAGE(PG8_SB(0, 1), b2 + hstep, voffB); PG8_STAGE(PG8_SA(0, 0), a2, voffA);
            PG8_WAIT_V(8); PG8_WAIT_L(0); PG8_BAR; if (doA1) { PG8_MMA(1, 0, At, B0); if (doB1) PG8_MMA(1, 1, At, B1); } PG8_BAR; PG8_SCHED;
            PG8_LDB(B0, 1, 0); PG8_LDB(B1, 1, 1); PG8_SCHED; PG8_LDA(At, 1, 0); PG8_STAGE(PG8_SA(0, 1), a2 + hstep, voffA);
            PG8_WAIT_V(8); PG8_WAIT_L(0); PG8_BAR; PG8_MMA(0, 0, At, B0); if (doB1) PG8_MMA(0, 1, At, B1); PG8_BAR; PG8_SCHED;
            PG8_LDA(At, 1, 1); PG8_STAGE(PG8_SB(1, 0), b3, voffB); PG8_STAGE(PG8_SB(1, 1), b3 + hstep, voffB); PG8_STAGE(PG8_SA(1, 0), a3, voffA);
            PG8_WAIT_V(8); PG8_WAIT_L(0); PG8_BAR; if (doA1) { PG8_MMA(1, 0, At, B0); if (doB1) PG8_MMA(1, 1, At, B1); } PG8_BAR; PG8_SCHED;
            } else {
            PG8_LDB(B0, 0, 0); PG8_SCHED; PG8_LDA(At, 0, 0); PG8_STAGE(PG8_SA(1, 1), a1 + hstep, voffA);
            PG8_WAIT_L(8); PG8_BAR; PG8_WAIT_L(0); PG8_MMA(0, 0, At, B0); PG8_BAR; PG8_SCHED;
            PG8_LDB(B1, 0, 1); PG8_STAGE(PG8_SB(0, 0), b2, voffB);
            PG8_BAR; PG8_WAIT_L(0); PG8_MMA(0, 1, At, B1); PG8_BAR;
            PG8_LDA(At, 0, 1); PG8_STAGE(PG8_SA(0, 0), a2, voffA);
            PG8_BAR; PG8_WAIT_L(0); PG8_MMA(1, 0, At, B0); PG8_BAR; PG8_SCHED;
            PG8_STAGE(PG8_SB(0, 1), b2 + hstep, voffB);
            PG8_WAIT_V(6); PG8_BAR; PG8_MMA(1, 1, At, B1); PG8_BAR;
            PG8_LDB(B0, 1, 0); PG8_SCHED; PG8_LDA(At, 1, 0); PG8_STAGE(PG8_SA(0, 1), a2 + hstep, voffA);
            PG8_WAIT_L(8); PG8_BAR; PG8_WAIT_L(0); PG8_MMA(0, 0, At, B0); PG8_BAR; PG8_SCHED;
            PG8_LDB(B1, 1, 1); PG8_STAGE(PG8_SB(1, 0), b3, voffB);
            PG8_BAR; PG8_WAIT_L(0); PG8_MMA(0, 1, At, B1); PG8_BAR;
            PG8_LDA(At, 1, 1); PG8_STAGE(PG8_SA(1, 0), a3, voffA);
            PG8_BAR; PG8_WAIT_L(0); PG8_MMA(1, 0, At, B0); PG8_BAR; PG8_SCHED;
            PG8_STAGE(PG8_SB(1, 1), b3 + hstep, voffB);
            PG8_WAIT_V(6); PG8_BAR; PG8_MMA(1, 1, At, B1); PG8_BAR;
            }
        }
        if constexpr (ALIGN_EPI) { if (wr == 0) PG8_BAR; }
        if constexpr (!Epi::AFTER_DRAIN) { E(acc, cur, wr, wc, fr, fq, pf); S.done(cur); }
        if (!has_next) break;
#pragma unroll
        for (int a = 0; a < 2; ++a)
#pragma unroll
            for (int b = 0; b < 2; ++b)
#pragma unroll
                for (int m = 0; m < 4; ++m)
#pragma unroll
                    for (int n = 0; n < 2; ++n) acc[a][b][m][n] = (f32x4){0.f, 0.f, 0.f, 0.f};
        cur = nxt; cA = nA; cB = nB; ++ui;
        if constexpr (ALIGN_EPI) { if (wr == 1) PG8_BAR; }
    }
    PG8_WAIT_V(0);
    if constexpr (!ALIGN_EPI) { if (wr == 0) PG8_BAR; }
    PG8_BAR;
    if constexpr (Epi::AFTER_DRAIN) { E.fused(acc, cur, wr, wc, fr, fq, lds, wid, lane); S.done(cur); }
#undef PG8_SA
#undef PG8_SB
#undef PG8_STAGE
#undef PG8_LDA
#undef PG8_LDB
#undef PG8_MMA
#undef PG8_WAIT_V
#undef PG8_WAIT_L
#undef PG8_BAR
#undef PG8_SCHED
}
}
namespace att {
using bf16 = __hip_bfloat16;
constexpr int   D = 128, NW = 8, QBLK = 32, KVBLK = 64;
constexpr float SCALE = 0.088388347648318440f;
constexpr float THR = 8.f;
constexpr int SDEPTH = 2;
constexpr int LDQ = 1536, LDK = 1536, LDO = 1024;
constexpr size_t SHM_V = KVBLK * D * 2, SHM_K = KVBLK * D * 2, SHM_ATTN = 3 * SHM_V + 3 * SHM_K + NW * 64 * 4;

using bf16x8 = __attribute__((ext_vector_type(8))) short;
using s16x4  = __attribute__((ext_vector_type(4))) short;
using f32x16 = __attribute__((ext_vector_type(16))) float;
using f32x8  = __attribute__((ext_vector_type(8))) float;
using u32x4  = __attribute__((ext_vector_type(4))) unsigned;
#define KSWZ(row, colB) ((row) * 256 + ((colB) ^ (((row) & 7) << 4)))
#define SBAR() __builtin_amdgcn_sched_barrier(0)
__device__ __forceinline__ int crow(int r, int hi) { return (r & 3) + 8 * (r >> 2) + 4 * hi; }
__device__ __forceinline__ unsigned cvtpk(float lo, float hi) {
  unsigned r; asm volatile("v_cvt_pk_bf16_f32 %0, %1, %2" : "=v"(r) : "v"(lo), "v"(hi)); return r;
}
template <typename TIn> struct Stage;
template <> struct Stage<bf16>  { using T = bf16x8;
  __device__ static __forceinline__ T ld8(const bf16* p) { return *reinterpret_cast<const bf16x8*>(p); }
  __device__ static __forceinline__ bf16x8 tobf(T x) { return x; } };
template <> struct Stage<float> { using T = f32x8;
  __device__ static __forceinline__ T ld8(const float* p) { return *reinterpret_cast<const f32x8*>(p); }
  __device__ static __forceinline__ bf16x8 tobf(T x) {
    u32x4 w = {cvtpk(x[0], x[1]), cvtpk(x[2], x[3]), cvtpk(x[4], x[5]), cvtpk(x[6], x[7])}; return *reinterpret_cast<bf16x8*>(&w); } };

__device__ __forceinline__ void partialSM(f32x16& p0, f32x16& p1, float& m_reg, float& mn, float& alpha) {
  constexpr float C = SCALE * 1.4426950408889634f;
  float pmax = p0[0]; for (int r = 1; r < 16; ++r) pmax = fmaxf(pmax, p0[r]); for (int r = 0; r < 16; ++r) pmax = fmaxf(pmax, p1[r]);
  { auto rr = __builtin_amdgcn_permlane32_swap(__float_as_uint(pmax), __float_as_uint(pmax), false, false);
    pmax = fmaxf(__uint_as_float(rr[0]), __uint_as_float(rr[1])); }
  if (__builtin_expect(__all(pmax - m_reg <= THR / SCALE), 1)) { mn = m_reg; alpha = 1.f; }
  else { mn = fmaxf(m_reg, pmax); alpha = __builtin_amdgcn_exp2f((m_reg - mn) * C); m_reg = mn; }
  float mnC = -mn * C;
  for (int r = 0; r < 16; ++r) p0[r] = fmaf(p0[r], C, mnC); for (int r = 0; r < 16; ++r) p1[r] = fmaf(p1[r], C, mnC);
  for (int r = 0; r < 16; ++r) p0[r] = __builtin_amdgcn_exp2f(p0[r]);
}
__device__ __forceinline__ void partialSM_fixed(f32x16& p0, f32x16& p1, float mnC) {
  constexpr float C = SCALE * 1.4426950408889634f;
  (void)mnC; (void)p1;
  for (int r = 0; r < 16; ++r) p0[r] = __builtin_amdgcn_exp2f(p0[r]);
}
__device__ __forceinline__ void finishSM(f32x16& p0, f32x16& p1, float alpha, f32x16& lacc, bf16x8& pa0, bf16x8& pa1, bf16x8& pa2, bf16x8& pa3) {
  for (int r = 0; r < 16; ++r) p1[r] = __builtin_amdgcn_exp2f(p1[r]);
  (void)alpha;
  for (int r = 0; r < 16; ++r) asm("v_add_f32 %0, %0, %1" : "+v"(lacc[r]) : "v"(p0[r]));
  for (int r = 0; r < 16; ++r) asm("v_add_f32 %0, %0, %1" : "+v"(lacc[r]) : "v"(p1[r]));
#define PK4(P, BASE, OUT) do { unsigned a0 = cvtpk(P[BASE + 0], P[BASE + 1]), a1 = cvtpk(P[BASE + 2], P[BASE + 3]);   \
    unsigned b0 = cvtpk(P[BASE + 4], P[BASE + 5]), b1 = cvtpk(P[BASE + 6], P[BASE + 7]);                              \
    auto r0 = __builtin_amdgcn_permlane32_swap(a0, b0, false, false); auto r1 = __builtin_amdgcn_permlane32_swap(a1, b1, false, false); \
    u32x4 w = {r0[0], r1[0], r0[1], r1[1]}; OUT = *reinterpret_cast<bf16x8*>(&w); } while (0)
  PK4(p0, 0, pa0); PK4(p0, 8, pa1); PK4(p1, 0, pa2); PK4(p1, 8, pa3);
#undef PK4
}
__device__ __forceinline__ void qkt(f32x16& p0, f32x16& p1, const bf16* Ks, const bf16x8* qr, int r32, int hi, const f32x16& iv) {
#pragma unroll
  for (int d0 = 0; d0 < 8; ++d0) { int cb = (d0 * 16 + hi * 8) * 2;
    bf16x8 b0 = *reinterpret_cast<const bf16x8*>((const char*)Ks + KSWZ(r32, cb));
    bf16x8 b1 = *reinterpret_cast<const bf16x8*>((const char*)Ks + KSWZ(32 + r32, cb));
    p0 = __builtin_amdgcn_mfma_f32_32x32x16_bf16(b0, qr[d0], d0 == 0 ? iv : p0, 0, 0, 0);
    p1 = __builtin_amdgcn_mfma_f32_32x32x16_bf16(b1, qr[d0], d0 == 0 ? iv : p1, 0, 0, 0); }
}
__device__ __forceinline__ int v_st(int k, int c) { const int kk = (k & ~0xC) | ((k & 4) << 1) | ((k & 8) >> 1); return ((kk >> 3) * 4 + (c >> 5)) * 512 + ((kk & 7) * 32 + (c & 31)) * 2; }
__device__ __forceinline__ int v_rd_base(int lane) { return ((lane & 3) << 3) | (((lane >> 2) & 3) << 6) | (((lane >> 4) & 1) << 5) | (((lane >> 5) & 1) << 8); }
constexpr int v_rd_off(int d0, int ks, int half) { return d0 * 512 + ks * 4096 + half * 2048; }
template <int OFF> __device__ __forceinline__ s16x4 tr_read(int vb) {
  s16x4 r; asm volatile("ds_read_b64_tr_b16 %0, %1 offset:%2" : "=&v"(r) : "v"(vb), "i"(OFF) : "memory"); return r;
}
template <int D0> __device__ __forceinline__ void pv_one(f32x16& od, int vb, bf16x8 pa0, bf16x8 pa1, bf16x8 pa2, bf16x8 pa3) {
  const s16x4 l0 = tr_read<v_rd_off(D0, 0, 0)>(vb), h0 = tr_read<v_rd_off(D0, 0, 1)>(vb), l1 = tr_read<v_rd_off(D0, 1, 0)>(vb), h1 = tr_read<v_rd_off(D0, 1, 1)>(vb);
  const s16x4 l2 = tr_read<v_rd_off(D0, 2, 0)>(vb), h2 = tr_read<v_rd_off(D0, 2, 1)>(vb), l3 = tr_read<v_rd_off(D0, 3, 0)>(vb), h3 = tr_read<v_rd_off(D0, 3, 1)>(vb);
  asm volatile("s_waitcnt lgkmcnt(0)" ::: "memory"); SBAR();
#define PK(L, H) (bf16x8){L[0], L[1], L[2], L[3], H[0], H[1], H[2], H[3]}
  od = __builtin_amdgcn_mfma_f32_32x32x16_bf16(pa0, PK(l0, h0), od, 0, 0, 0);
  od = __builtin_amdgcn_mfma_f32_32x32x16_bf16(pa1, PK(l1, h1), od, 0, 0, 0);
  od = __builtin_amdgcn_mfma_f32_32x32x16_bf16(pa2, PK(l2, h2), od, 0, 0, 0);
  od = __builtin_amdgcn_mfma_f32_32x32x16_bf16(pa3, PK(l3, h3), od, 0, 0, 0);
#undef PK
}
__device__ __forceinline__ void pv_d0(f32x16* o, int vb, bf16x8 pa0, bf16x8 pa1, bf16x8 pa2, bf16x8 pa3) {
  pv_one<0>(o[0], vb, pa0, pa1, pa2, pa3); pv_one<1>(o[1], vb, pa0, pa1, pa2, pa3); pv_one<2>(o[2], vb, pa0, pa1, pa2, pa3); pv_one<3>(o[3], vb, pa0, pa1, pa2, pa3);
}

template <typename TQ>
__device__ __forceinline__ void attn_dense_body(const TQ* __restrict__ Qb, const bf16* __restrict__ Kh, const bf16* __restrict__ Vh,
                                                bf16* __restrict__ Ob, int seq, char* lds, float mraw) {
  using SQ = Stage<TQ>;
  const float mnC = -mraw * (SCALE * 1.4426950408889634f);
  f32x16 iv; for (int r = 0; r < 16; ++r) iv[r] = mnC;
  typedef __attribute__((address_space(3))) unsigned lds_u32;
  const int tid = opaque_tid(), wid = __builtin_amdgcn_readfirstlane(tid >> 6), lane = tid & 63, r32 = lane & 31, hi = lane >> 5;
  const unsigned ldsb = (unsigned)(uintptr_t)lds;
  bf16* V_lds = (bf16*)lds; bf16* K_lds = (bf16*)(lds + 3 * SHM_V);
  float* ws = (float*)(lds + 3 * SHM_V + 3 * SHM_K) + wid * 64; float* li_l = ws; float* al_l = ws + 32;
  f32x16 lacc = {}; f32x16 o[4] = {}; bf16x8 qr[8];
  const TQ* Qw = Qb + (long)(wid * QBLK + r32) * LDQ + hi * 8;
#pragma unroll
  for (int d0 = 0; d0 < 8; ++d0) qr[d0] = SQ::tobf(SQ::ld8(Qw + d0 * 16));
  long ksrc[2], vsrc[2];
#pragma unroll
  for (int t = 0; t < 2; ++t) { const int q = (wid * 2 + t) * 64 + lane;
    { const int row = q >> 4, c = (q & 15) ^ (row & 7); ksrc[t] = (long)row * LDK + c * 8; }
    { const int off = q * 16, sub = off >> 9, kk = (sub >> 2) * 8 + ((off & 511) >> 6), cc = (sub & 3) * 32 + ((off & 63) >> 1);
      const int k = (kk & ~0xC) | ((kk & 4) << 1) | ((kk & 8) >> 1); vsrc[t] = (long)k * LDK + cc; } }
  const int vb0 = (int)ldsb + v_rd_base(lane);
#define DMA_TILE(tile, buf) do { const bf16* kp_ = Kh + (long)(tile) * KVBLK * LDK; const bf16* vp_ = Vh + (long)(tile) * KVBLK * LDK; _Pragma("unroll") for (int t_ = 0; t_ < 2; ++t_) { \
      __builtin_amdgcn_global_load_lds((const unsigned*)(kp_ + ksrc[t_]), (lds_u32*)(size_t)(ldsb + 3 * (unsigned)SHM_V + (unsigned)(buf) * (unsigned)SHM_K + (unsigned)(wid * 2 + t_) * 1024u), 16, 0, 0); \
      __builtin_amdgcn_global_load_lds((const unsigned*)(vp_ + vsrc[t_]), (lds_u32*)(size_t)(ldsb + (unsigned)(buf) * (unsigned)SHM_V + (unsigned)(wid * 2 + t_) * 1024u), 16, 0, 0); } } while (0)
#define KBUF(b) ((bf16*)((char*)K_lds + (b) * SHM_K))
#define VBUF(b) (vb0 + (b) * (int)SHM_V)
#define LANDED_BAR() do { asm volatile("s_waitcnt vmcnt(0)" ::: "memory"); __syncthreads(); } while (0)
#define RESC(a) do { if (__any((a) < 1.f)) { if (hi == 0) al_l[r32] = (a); asm volatile("s_waitcnt lgkmcnt(0)" ::: "memory"); \
    for (int d = 0; d < 4; ++d) for (int r = 0; r < 16; ++r) o[d][r] *= al_l[crow(r, hi)]; } } while (0)
  f32x16 pA0, pA1, pB0, pB1; bf16x8 pa0, pa1, pa2, pa3; const int NT = seq / KVBLK;
  DMA_TILE(0, 0); DMA_TILE(1, 1); DMA_TILE(2, 2);
  asm volatile("s_waitcnt vmcnt(8)" ::: "memory"); __syncthreads();
  qkt(pA0, pA1, KBUF(0), qr, r32, hi, iv); partialSM_fixed(pA0, pA1, mnC);
  asm volatile("s_waitcnt vmcnt(4)" ::: "memory"); __syncthreads();
  int bprev = 0, bcur = 1, bnext = 2;
  for (int j = 1; j + 1 < NT; j += 2) {
    SBAR(); qkt(pB0, pB1, KBUF(bcur), qr, r32, hi, iv);
    finishSM(pA0, pA1, 1.f, lacc, pa0, pa1, pa2, pa3); SBAR();
    pv_d0(o, VBUF(bprev), pa0, pa1, pa2, pa3); partialSM_fixed(pB0, pB1, mnC);
    LANDED_BAR();
    if (j + 2 < NT) DMA_TILE(j + 2, bprev);
    SBAR(); qkt(pA0, pA1, KBUF(bnext), qr, r32, hi, iv);
    finishSM(pB0, pB1, 1.f, lacc, pa0, pa1, pa2, pa3); SBAR();
    pv_d0(o, VBUF(bcur), pa0, pa1, pa2, pa3); partialSM_fixed(pA0, pA1, mnC);
    LANDED_BAR();
    if (j + 3 < NT) DMA_TILE(j + 3, bcur);
    { const int t0_ = bprev; bprev = bnext; bnext = bcur; bcur = t0_; }
  }
  SBAR(); qkt(pB0, pB1, KBUF(bcur), qr, r32, hi, iv);
  finishSM(pA0, pA1, 1.f, lacc, pa0, pa1, pa2, pa3); SBAR();
  pv_d0(o, VBUF(bprev), pa0, pa1, pa2, pa3); partialSM_fixed(pB0, pB1, mnC);
  finishSM(pB0, pB1, 1.f, lacc, pa0, pa1, pa2, pa3); SBAR();
  pv_d0(o, VBUF(bcur), pa0, pa1, pa2, pa3);
  float l_reg = 0; for (int r = 0; r < 16; ++r) l_reg += lacc[r];
  { auto rr = __builtin_amdgcn_permlane32_swap(__float_as_uint(l_reg), __float_as_uint(l_reg), false, false); l_reg = __uint_as_float(rr[0]) + __uint_as_float(rr[1]); }
  if (hi == 0) li_l[r32] = l_reg; asm volatile("s_waitcnt lgkmcnt(0)" ::: "memory");
  float rli[16];
#pragma unroll
  for (int r = 0; r < 16; ++r) rli[r] = __builtin_amdgcn_rcpf(li_l[crow(r, hi)]);
  bf16* Ow = Ob + (long)(wid * QBLK) * LDO;
#pragma unroll
  for (int r = 0; r < 16; ++r) { int orow = crow(r, hi);
#pragma unroll
    for (int d0 = 0; d0 < 4; ++d0) { const float v = o[d0][r] * rli[r]; const float nb = __shfl_xor(v, 1);
      if (!(r32 & 1)) *reinterpret_cast<unsigned*>(Ow + (long)orow * LDO + d0 * 32 + r32) = cvtpk(v, nb); } }
#undef DMA_TILE
#undef KBUF
#undef VBUF
#undef LANDED_BAR
#undef RESC
}
}

constexpr int NB = 8, SEQ = 4096, CTX = 256, DM = 1024, FF = 2816, NFF2 = 2 * FF, NQKV = 1536, NCONV = 3072;
constexpr int TPB = CTX + SEQ;
constexpr int M = NB * TPB;
constexpr int NMOD = 9 * 1024;
constexpr int MODW = 4 * NMOD;
constexpr int KSPLIT = 8;
constexpr int NWAVES = 8, NTHREADS = 512;
constexpr float EPS = 1e-6f;
constexpr size_t al256(size_t x) { return (x + 255) / 256 * 256; }
constexpr size_t WS_BAR = 0, BAR_BYTES = 16384;
constexpr size_t WS_MOD = BAR_BYTES;
constexpr size_t WS_ROPE = al256(WS_MOD + (size_t)9 * MODW * 4);
constexpr size_t WS_PART = al256(WS_ROPE + 2 * 64 * 32 * 4);
constexpr size_t WS_WFI = al256(WS_PART + (size_t)KSPLIT * 9 * MODW * 4);
constexpr size_t WS_WFO = al256(WS_WFI + (size_t)8 * NFF2 * DM * 2);
constexpr size_t WS_WCI = al256(WS_WFO + (size_t)8 * DM * FF * 2);
constexpr size_t WS_WCO = al256(WS_WCI + (size_t)2 * NCONV * DM * 2);
constexpr size_t WS_WQKV = al256(WS_WCO + (size_t)2 * DM * DM * 2);
constexpr size_t WS_WO = al256(WS_WQKV + (size_t)2 * NQKV * DM * 2);
constexpr size_t WS_XRES = al256(WS_WO + (size_t)2 * DM * DM * 2);
constexpr size_t WS_XN = al256(WS_XRES + (size_t)M * DM * 4);
constexpr size_t WS_BIG = al256(WS_XN + (size_t)M * DM * 2);
constexpr size_t WS_XB = al256(WS_BIG + (size_t)M * NCONV * 2);
constexpr size_t WS_RSS = al256(WS_XB + (size_t)M * DM * 2);
constexpr size_t WS_SW = al256(WS_RSS + (size_t)12 * M * 4);
constexpr size_t WS_END = al256(WS_SW + (size_t)12 * 9 * NFF2 * 4);
constexpr int LDS_BYTES = 131072 + 1024;

typedef unsigned short bf16;
typedef unsigned v4u __attribute__((ext_vector_type(4)));
typedef unsigned v2u __attribute__((ext_vector_type(2)));
typedef float f32x4 __attribute__((ext_vector_type(4)));
typedef float f32x2 __attribute__((ext_vector_type(2)));
#define LAS __attribute__((address_space(3)))
#define LDS_WAIT() asm volatile("s_waitcnt lgkmcnt(0)" ::: "memory")
__device__ __forceinline__ unsigned pk2(float lo, float hi) { return pg8::cvt_pk_bf16(lo, hi); }
__device__ __forceinline__ float bflo(unsigned w) { return __uint_as_float(w << 16); }
__device__ __forceinline__ float bfhi(unsigned w) { return __uint_as_float(w & 0xffff0000u); }
__device__ __forceinline__ float wave_sum(float v) {
#pragma unroll
    for (int o = 1; o < 64; o <<= 1) v += __shfl_xor(v, o);
    return v;
}

#define XB_TMO      128
#define XB_XCNT(j)  (256  + 64 * (j))
#define XB_XSUB(j)  (1280 + 64 * (j))
#define XB_XGEN(j)  (2304 + 64 * (j))
#define XB_TOP      3328
#define XB_TOPGEN   3392
#define XCD_BAR_WORDS 3456
#define XB_SPIN_CAP (1u << 18)

__device__ __forceinline__ unsigned xb_ld(unsigned* p)              { return __hip_atomic_load(p, __ATOMIC_RELAXED, __HIP_MEMORY_SCOPE_AGENT); }
__device__ __forceinline__ unsigned xb_add(unsigned* p, unsigned v) { return __hip_atomic_fetch_add(p, v, __ATOMIC_RELAXED, __HIP_MEMORY_SCOPE_AGENT); }
__device__ __forceinline__ unsigned xb_xcc_id() { return (unsigned)__builtin_amdgcn_s_getreg((3 << 11) | 20) & 0xFu; }
#define XB_SPIN(cond, bar) do { unsigned _sp = 0; while (cond) { __builtin_amdgcn_s_sleep(1); \
    if ((++_sp & 255u) == 0u) { if (xb_ld(&(bar)[XB_TMO])) break; if (_sp > XB_SPIN_CAP) { atomicAdd(&(bar)[XB_TMO], 1u); break; } } } } while (0)

struct XcdBarrier {
    unsigned* bar; unsigned x;
    volatile LAS unsigned* st;
};

__device__ __forceinline__ XcdBarrier xcd_barrier_post(unsigned* bar, volatile LAS unsigned* st) {
    XcdBarrier b; b.bar = bar; b.x = xb_xcc_id(); b.st = st;
    if (threadIdx.x == 0) (void)xb_add(&bar[XB_XCNT(b.x)], 1u);
    return b;
}
__device__ __forceinline__ void xcd_barrier_complete(unsigned* bar, unsigned x, unsigned& nloc, unsigned& nx) {
    const unsigned G = gridDim.x * gridDim.y * gridDim.z;
    unsigned sum, cnt, mine, sp = 0u;
    for (;;) {
        sum = 0u; cnt = 0u; mine = 0u;
#pragma unroll
        for (unsigned j = 0; j < 16; ++j) { const unsigned c = xb_ld(&bar[XB_XCNT(j)]); sum += c; cnt += (c > 0u) ? 1u : 0u; mine = (j == x) ? c : mine; }
        if (sum == G) break;
        __builtin_amdgcn_s_sleep(1);
        if ((++sp & 255u) == 0u) { if (xb_ld(&bar[XB_TMO])) break; if (sp > XB_SPIN_CAP) { atomicAdd(&bar[XB_TMO], 1u); break; } }
    }
    nloc = mine > 0u ? mine : 1u; nx = cnt > 0u ? cnt : 1u;
}

__device__ __forceinline__ void xcd_barrier(const XcdBarrier& b) {
    asm volatile("s_waitcnt vmcnt(0)" ::: "memory");
    __syncthreads();
    if (threadIdx.x == 0) {
        unsigned* bar = b.bar;
        __builtin_amdgcn_s_waitcnt(0);
        unsigned nloc = b.st[0], nx = b.st[1];
        if (nloc == 0u) { xcd_barrier_complete(bar, b.x, nloc, nx); b.st[0] = nloc; b.st[1] = nx; }
        const unsigned old = xb_add(&bar[XB_XSUB(b.x)], 1u);
        const unsigned gen = old / nloc;
        if (old + 1u == (gen + 1u) * nloc) {
            __builtin_amdgcn_fence(__ATOMIC_RELEASE, "agent");
            asm volatile("s_waitcnt vmcnt(0)" ::: "memory");
            const unsigned og = xb_add(&bar[XB_TOP], 1u);
            const unsigned tg = og / nx;
            if (og + 1u == (tg + 1u) * nx) xb_add(&bar[XB_TOPGEN], 1u);
            else XB_SPIN(xb_ld(&bar[XB_TOPGEN]) == tg, bar);
            __builtin_amdgcn_fence(__ATOMIC_ACQUIRE, "agent");
            xb_add(&bar[XB_XGEN(b.x)], 1u);
            asm volatile("s_waitcnt vmcnt(0)" ::: "memory");
        } else {
            XB_SPIN(xb_ld(&bar[XB_XGEN(b.x)]) == gen, bar);
            __builtin_amdgcn_fence(__ATOMIC_ACQUIRE, "agent");
            asm volatile("s_waitcnt vmcnt(0)" ::: "memory");
        }
    }
    __syncthreads();
}

struct Args {
    const float *x, *c, *ctx, *c_ctx, *ada_w, *ada_b, *norm_g, *final_g, *ffn_w_in, *ffn_w_out, *conv_w_in, *conv_w, *conv_w_out, *attn_w_qkv, *attn_q_g, *attn_k_g, *attn_w_o;
    float* out; unsigned char* ws;
};
__device__ __forceinline__ const void* karg_ptr(size_t off) { const char __attribute__((address_space(4)))* kp = (const char __attribute__((address_space(4)))*)__builtin_amdgcn_kernarg_segment_ptr(); asm volatile("" : "+s"(kp)); return *(const void* const __attribute__((address_space(4)))*)(kp + off); }
#define KARG(name) ((decltype(Args::name))karg_ptr(offsetof(Args, name)))

__device__ __forceinline__ void transpose_item(const float* W, int K, int N, bf16* WT, int mode, LAS float* scr, int item, int lane) {
    const int nblk = N / 32, kb = item / nblk, nb = item % nblk, k0 = 64 * kb, n0 = 32 * nb;
    int d0 = n0;
    if (mode == 1) { const int up = n0 >= FF ? 1 : 0, j = n0 - up * FF; d0 = 256 * (j >> 7) + 128 * up + (j & 127); }
    if (mode == 2 && n0 >= DM) { const int isv = n0 >= 2 * DM ? 1 : 0, j = n0 - DM - isv * DM; d0 = DM + 256 * (j >> 7) + 128 * isv + (j & 127); }
    { f32x4 t4[8]; const int nn = 4 * (lane & 7);
#pragma unroll
      for (int i = 0; i < 8; ++i) t4[i] = __builtin_nontemporal_load((const f32x4*)(W + (size_t)(k0 + 8 * i + (lane >> 3)) * N + n0 + nn));
#pragma unroll
      for (int i = 0; i < 8; ++i) { LAS float* d = scr + (8 * i + (lane >> 3)) * 33 + nn; d[0] = t4[i].x; d[1] = t4[i].y; d[2] = t4[i].z; d[3] = t4[i].w; } }
    LDS_WAIT(); asm volatile("" ::: "memory");
    const int c = lane & 7;
#pragma unroll
    for (int j = 0; j < 4; ++j) { const int n = (lane >> 3) + 8 * j; const LAS float* s = scr + (8 * c) * 33 + n;
        v4u o; o.x = pk2(s[0 * 33], s[1 * 33]); o.y = pk2(s[2 * 33], s[3 * 33]); o.z = pk2(s[4 * 33], s[5 * 33]); o.w = pk2(s[6 * 33], s[7 * 33]);
        __builtin_nontemporal_store(o, (v4u*)(WT + (size_t)(d0 + n) * K + k0 + 8 * c)); }
    LDS_WAIT(); asm volatile("" ::: "memory");
}

struct Ctx {
    LAS unsigned char* lds;
    int G, NGW, NT;
};
#define PHASE_IDS const int tid_ = opaque_tid(), lane_ = tid_ & 63, wave_ = __builtin_amdgcn_readfirstlane(tid_ >> 6), gw_ = (int)blockIdx.x * NWAVES + wave_, gt_ = (int)blockIdx.x * NTHREADS + tid_; (void)lane_; (void)gw_; (void)gt_

__device__ __forceinline__ void p0_weights(const Args& a, const Ctx& F) {
    PHASE_IDS;
    LAS float* scr = (LAS float*)(F.lds + wave_ * 16384);
    constexpr int I_FI = (DM / 64) * (NFF2 / 32), I_FO = (FF / 64) * (DM / 32), I_CI = (DM / 64) * (NCONV / 32), I_SQ = (DM / 64) * (DM / 32), I_QKV = (DM / 64) * (NQKV / 32);
    constexpr int NITEMS = 8 * I_FI + 8 * I_FO + 2 * I_CI + 2 * I_SQ + 2 * I_QKV + 2 * I_SQ;
    for (int it = gw_; it < NITEMS; it += F.NGW) {
        int r = it;
        if (r < 8 * I_FI) { const int m = r / I_FI; r -= m * I_FI; transpose_item(KARG(ffn_w_in) + (size_t)m * DM * NFF2, DM, NFF2, (bf16*)(KARG(ws) + WS_WFI) + (size_t)m * NFF2 * DM, 1, scr, r, lane_); continue; } r -= 8 * I_FI;
        if (r < 8 * I_FO) { const int m = r / I_FO; r -= m * I_FO; transpose_item(KARG(ffn_w_out) + (size_t)m * FF * DM, FF, DM, (bf16*)(KARG(ws) + WS_WFO) + (size_t)m * DM * FF, 0, scr, r, lane_); continue; } r -= 8 * I_FO;
        if (r < 2 * I_CI) { const int m = r / I_CI; r -= m * I_CI; transpose_item(KARG(conv_w_in) + (size_t)m * DM * NCONV, DM, NCONV, (bf16*)(KARG(ws) + WS_WCI) + (size_t)m * NCONV * DM, 2, scr, r, lane_); continue; } r -= 2 * I_CI;
        if (r < 2 * I_SQ) { const int m = r / I_SQ; r -= m * I_SQ; transpose_item(KARG(conv_w_out) + (size_t)m * DM * DM, DM, DM, (bf16*)(KARG(ws) + WS_WCO) + (size_t)m * DM * DM, 0, scr, r, lane_); continue; } r -= 2 * I_SQ;
        if (r < 2 * I_QKV) { const int m = r / I_QKV; r -= m * I_QKV; transpose_item(KARG(attn_w_qkv) + (size_t)m * DM * NQKV, DM, NQKV, (bf16*)(KARG(ws) + WS_WQKV) + (size_t)m * NQKV * DM, 0, scr, r, lane_); continue; } r -= 2 * I_QKV;
        { const int m = r / I_SQ; r -= m * I_SQ; transpose_item(KARG(attn_w_o) + (size_t)m * DM * DM, DM, DM, (bf16*)(KARG(ws) + WS_WO) + (size_t)m * DM * DM, 0, scr, r, lane_); }
    }
}

__device__ __forceinline__ void p0_ada_partial(const Args& a, const Ctx& F) {
    PHASE_IDS;
    __syncthreads();
    LAS float* s = (LAS float*)F.lds;
    for (int e = tid_; e < 9 * 1024; e += NTHREADS) { const int b = e >> 10, k = e & 1023; const float v = b < 8 ? KARG(c)[b * 1024 + k] : KARG(c_ctx)[k]; s[e] = v / (1.0f + __expf(-v)); }
    __syncthreads();
    float* part = (float*)(KARG(ws) + WS_PART);
    constexpr int NCG = MODW / 4, KC = 1024 / KSPLIT;
    for (int base_ = 0; base_ < NCG * KSPLIT; base_ += (F.NT >> 4) * 9) {
        const int it = base_ + (gt_ >> 4) * 9 + (gt_ & 15);
        if ((gt_ & 15) < 9 && it < NCG * KSPLIT) {
        const int cgp = it % NCG, kc = it / NCG, n = 4 * cgp, layer = n / NMOD, nn = n - layer * NMOD;
        const float* wp = KARG(ada_w) + ((size_t)layer * 1024 + kc * KC) * NMOD + nn;
        f32x4 acc[9];
#pragma unroll
        for (int b = 0; b < 9; ++b) acc[b] = (f32x4){0.f, 0.f, 0.f, 0.f};
        for (int k8 = 0; k8 < KC; k8 += 8) {
            f32x4 w[8];
#pragma unroll
            for (int q = 0; q < 8; ++q) w[q] = __builtin_nontemporal_load((const f32x4*)(wp + (size_t)(k8 + q) * NMOD));
#pragma unroll
            for (int b = 0; b < 9; ++b) { const f32x4 s0 = *(const LAS f32x4*)(s + b * 1024 + kc * KC + k8), s1 = *(const LAS f32x4*)(s + b * 1024 + kc * KC + k8 + 4);
                acc[b] = acc[b] + w[0] * s0.x + w[1] * s0.y + w[2] * s0.z + w[3] * s0.w + w[4] * s1.x + w[5] * s1.y + w[6] * s1.z + w[7] * s1.w; }
        }
#pragma unroll
        for (int b = 0; b < 9; ++b) *(f32x4*)(part + ((size_t)(kc * 9 + b)) * MODW + n) = acc[b];
        } }
    __syncthreads();
}
__device__ __forceinline__ void p0_rope_table(const Ctx& F) {
    PHASE_IDS;
    if (gt_ < 64 * 32) { const int pos = gt_ >> 5, f = gt_ & 31; const float inv = powf(10000.0f, -(float)f / 32.0f); const float ang = (float)pos * inv;
        float* t = (float*)(KARG(ws) + WS_ROPE); t[gt_] = cosf(ang); t[2048 + gt_] = sinf(ang); }
}
__device__ __forceinline__ void p1_ada_reduce(const Args& a, const Ctx& F) {
    PHASE_IDS;
    const float* part = (const float*)(KARG(ws) + WS_PART); float* mod = (float*)(KARG(ws) + WS_MOD);
    for (int e = gt_; e < 9 * MODW; e += F.NT) { const int b = e / MODW, n = e - b * MODW; float sacc = KARG(ada_b)[n];
#pragma unroll
        for (int kc = 0; kc < KSPLIT; ++kc) sacc += part[((size_t)(kc * 9 + b)) * MODW + n];
        mod[e] = sacc; }
}

template <int R> __device__ __forceinline__ void prep_rows(int row0, int stride, int lane_, const float* g, const float* modb, const float* x_in, const float* ctx_in, float* xres, bf16* xs, float* rss) {
    f32x4 v[R][4]; float ss[R]; int mi[R];
#pragma unroll
    for (int r = 0; r < R; ++r) { const int row = row0 + r * stride; const int b = row / TPB, t = row - b * TPB; const bool isctx = t < CTX; mi[r] = isctx ? 8 : b;
        const float* src = isctx ? ctx_in + (size_t)(b * CTX + t) * DM : x_in + (size_t)(b * SEQ + t - CTX) * DM;
#pragma unroll
        for (int j = 0; j < 4; ++j) v[r][j] = __builtin_nontemporal_load((const f32x4*)src + lane_ + 64 * j); }
#pragma unroll
    for (int r = 0; r < R; ++r) { float s_ = 0.f;
#pragma unroll
        for (int j = 0; j < 4; ++j) s_ += (v[r][j].x * v[r][j].x + v[r][j].y * v[r][j].y) + (v[r][j].z * v[r][j].z + v[r][j].w * v[r][j].w);
        ss[r] = s_; }
#pragma unroll
    for (int r = 0; r < R; ++r)
#pragma unroll
        for (int j = 0; j < 4; ++j) __builtin_nontemporal_store(v[r][j], (f32x4*)(xres + (size_t)(row0 + r * stride) * DM) + lane_ + 64 * j);
#pragma unroll
    for (int o = 1; o < 64; o <<= 1) {
#pragma unroll
        for (int r = 0; r < R; ++r) ss[r] += __shfl_xor(ss[r], o); }
#pragma unroll
    for (int r = 0; r < R; ++r) { const float* sc = modb + (size_t)mi[r] * MODW + 1024;
        if (lane_ == 0) rss[row0 + r * stride] = ss[r];
#pragma unroll
        for (int j = 0; j < 4; ++j) { const f32x4 gj = ((const f32x4*)g)[lane_ + 64 * j], sj = ((const f32x4*)sc)[lane_ + 64 * j];
            const f32x4 o = v[r][j] * gj * (sj + 1.0f);
            v2u w; w.x = pk2(o.x, o.y); w.y = pk2(o.z, o.w); ((v2u*)(xs + (size_t)(row0 + r * stride) * DM))[lane_ + 64 * j] = w; } }
}
__device__ __forceinline__ void prep_phase(const Args& a, const Ctx& F) {
    PHASE_IDS;
    const float* g = KARG(norm_g); const float* modb = (const float*)(KARG(ws) + WS_MOD);
    float* xres = (float*)(KARG(ws) + WS_XRES); bf16* xs = (bf16*)(KARG(ws) + WS_XN); float* rss = (float*)(KARG(ws) + WS_RSS); const float* x_in = KARG(x); const float* ctx_in = KARG(ctx);
    int row = gw_;
    for (; row + 3 * F.NGW < M; row += 4 * F.NGW) prep_rows<4>(row, F.NGW, lane_, g, modb, x_in, ctx_in, xres, xs, rss);
    for (; row < M; row += F.NGW) prep_rows<1>(row, F.NGW, lane_, g, modb, x_in, ctx_in, xres, xs, rss);
}
__device__ __forceinline__ int sl_cols(int sl) { const int layer = sl / 3, sub = sl - layer * 3; return sub != 1 ? NFF2 : ((layer & 1) ? NQKV : NCONV); }
__device__ __forceinline__ const bf16* sl_weights(unsigned char* ws, int sl) { const int layer = sl / 3, sub = sl - layer * 3;
    if (sub != 1) return (const bf16*)(ws + WS_WFI) + (size_t)(layer * 2 + (sub >> 1)) * NFF2 * DM;
    return (layer & 1) ? (const bf16*)(ws + WS_WQKV) + (size_t)(layer >> 1) * NQKV * DM : (const bf16*)(ws + WS_WCI) + (size_t)(layer >> 1) * NCONV * DM; }
__device__ __forceinline__ void bias_phase(const Args& a, const Ctx& F) {
    PHASE_IDS;
    unsigned char* ws = KARG(ws); const float* mod = (const float*)(ws + WS_MOD); float* sw = (float*)(ws + WS_SW);
    constexpr int NCOLS = 8 * NFF2 + 2 * NCONV + 2 * NQKV;
    const int per = (NCOLS + F.NGW - 1) / F.NGW; const int c0 = gw_ * per; const int c1 = (c0 + per < NCOLS) ? c0 + per : NCOLS;
    int sl = 0, base = 0, cur = -1; float shr[9][16];
#pragma unroll
    for (int mi = 0; mi < 9; ++mi)
#pragma unroll
        for (int k = 0; k < 16; ++k) shr[mi][k] = 0.f;
    for (int c = c0; c < c1; ++c) {
        while (c >= base + sl_cols(sl)) { base += sl_cols(sl); ++sl; }
        if (sl != cur) { cur = sl; const int layer = sl / 3, sub = sl - layer * 3; const float* sh = mod + layer * NMOD + (sub * 3) * 1024 + 16 * lane_;
#pragma unroll
            for (int mi = 0; mi < 9; ++mi)
#pragma unroll
                for (int q = 0; q < 4; ++q) { const f32x4 t4 = *(const f32x4*)(sh + (size_t)mi * MODW + 4 * q); shr[mi][4 * q] = t4.x; shr[mi][4 * q + 1] = t4.y; shr[mi][4 * q + 2] = t4.z; shr[mi][4 * q + 3] = t4.w; } }
        const int n = c - base; const bf16* wrow = sl_weights(ws, sl) + (size_t)n * DM + 16 * lane_;
        const v4u w0 = *(const v4u*)wrow, w1 = *(const v4u*)(wrow + 8);
        float wf[16];
#pragma unroll
        for (int q = 0; q < 4; ++q) { wf[2 * q] = bflo(w0[q]); wf[2 * q + 1] = bfhi(w0[q]); wf[8 + 2 * q] = bflo(w1[q]); wf[8 + 2 * q + 1] = bfhi(w1[q]); }
        float accb[9];
#pragma unroll
        for (int mi = 0; mi < 9; ++mi) { float t_ = 0.f;
#pragma unroll
            for (int k = 0; k < 16; ++k) t_ += wf[k] * shr[mi][k];
            accb[mi] = t_; }
#pragma unroll
        for (int o = 1; o < 64; o <<= 1) {
#pragma unroll
            for (int mi = 0; mi < 9; ++mi) accb[mi] += __shfl_xor(accb[mi], o); }
#pragma unroll
        for (int mi = 0; mi < 9; ++mi) if (lane_ == mi) sw[((size_t)sl * 9 + mi) * NFF2 + n] = accb[mi];
    }
}
template <int R> __device__ __forceinline__ void final_rows(int idx0, int stride, int lane_, const float* xres, const float* fg, float* out) {
    f32x4 v[R][4]; float ss[R];
#pragma unroll
    for (int r = 0; r < R; ++r) { const int idx = idx0 + r * stride, b = idx / SEQ, t = idx - b * SEQ; const float* src = xres + (size_t)(b * TPB + CTX + t) * DM;
#pragma unroll
        for (int j = 0; j < 4; ++j) v[r][j] = __builtin_nontemporal_load((const f32x4*)src + lane_ + 64 * j); }
#pragma unroll
    for (int r = 0; r < R; ++r) { float s_ = 0.f;
#pragma unroll
        for (int j = 0; j < 4; ++j) s_ += (v[r][j].x * v[r][j].x + v[r][j].y * v[r][j].y) + (v[r][j].z * v[r][j].z + v[r][j].w * v[r][j].w);
        ss[r] = s_; }
#pragma unroll
    for (int o = 1; o < 64; o <<= 1) {
#pragma unroll
        for (int r = 0; r < R; ++r) ss[r] += __shfl_xor(ss[r], o); }
#pragma unroll
    for (int r = 0; r < R; ++r) { const float rstd = 1.0f / sqrtf(ss[r] * (1.0f / DM) + EPS);
#pragma unroll
        for (int j = 0; j < 4; ++j) { const f32x4 gj = ((const f32x4*)fg)[lane_ + 64 * j]; __builtin_nontemporal_store(v[r][j] * rstd * gj, (f32x4*)(out + (size_t)(idx0 + r * stride) * DM) + lane_ + 64 * j); } }
}
__device__ __forceinline__ void final_phase(const Args& a, const Ctx& F) {
    PHASE_IDS;
    const float* xres = (const float*)(KARG(ws) + WS_XRES); const float* fg = KARG(final_g); float* out = KARG(out);
    int idx = gw_;
    for (; idx + 3 * F.NGW < NB * SEQ; idx += 4 * F.NGW) final_rows<4>(idx, F.NGW, lane_, xres, fg, out);
    for (; idx < NB * SEQ; idx += F.NGW) final_rows<1>(idx, F.NGW, lane_, xres, fg, out);
}

template <int R> __device__ __forceinline__ void conv_rows(int row0, int lane_, const bf16* bu, bf16* z, const float* cw) {
#pragma unroll
    for (int jj = 0; jj < 2; ++jj) { const int d = 8 * lane_ + 512 * jj;
        v4u ur[R + 2], br[R];
#pragma unroll
        for (int i = 0; i < R + 2; ++i) { const int rr = row0 - 1 + i; const bool ok = rr >= 0 && rr < M; ur[i] = *(const v4u*)(bu + (size_t)(ok ? rr : row0) * 2048 + DM + d); }
#pragma unroll
        for (int i = 0; i < R; ++i) br[i] = *(const v4u*)(bu + (size_t)(row0 + i) * 2048 + d);
        const f32x4 w0a = *(const f32x4*)(cw + d), w0b = *(const f32x4*)(cw + d + 4), w1a = *(const f32x4*)(cw + DM + d), w1b = *(const f32x4*)(cw + DM + d + 4), w2a = *(const f32x4*)(cw + 2 * DM + d), w2b = *(const f32x4*)(cw + 2 * DM + d + 4);
        const float w0[8] = {w0a.x, w0a.y, w0a.z, w0a.w, w0b.x, w0b.y, w0b.z, w0b.w}, w1[8] = {w1a.x, w1a.y, w1a.z, w1a.w, w1b.x, w1b.y, w1b.z, w1b.w}, w2[8] = {w2a.x, w2a.y, w2a.z, w2a.w, w2b.x, w2b.y, w2b.z, w2b.w};
#pragma unroll
        for (int i = 0; i < R; ++i) { const int row = row0 + i, b = row / TPB, t = row - b * TPB; const float mp = (t != 0 && t != CTX) ? 1.f : 0.f, mn = (t != CTX - 1 && t != TPB - 1) ? 1.f : 0.f;
            v4u o;
#pragma unroll
            for (int q = 0; q < 4; ++q) {
                const float ylo = mp * w0[2 * q] * bflo(ur[i][q]) + w1[2 * q] * bflo(ur[i + 1][q]) + mn * w2[2 * q] * bflo(ur[i + 2][q]);
                const float yhi = mp * w0[2 * q + 1] * bfhi(ur[i][q]) + w1[2 * q + 1] * bfhi(ur[i + 1][q]) + mn * w2[2 * q + 1] * bfhi(ur[i + 2][q]);
                o[q] = pk2(bflo(br[i][q]) * ylo, bfhi(br[i][q]) * yhi); }
            *(v4u*)(z + (size_t)row * DM + d) = o; } }
}
__device__ __forceinline__ void conv_phase(const Args& a, const Ctx& F, int j) {
    PHASE_IDS;
    const bf16* bcv = (const bf16*)(KARG(ws) + WS_BIG); bf16* z = (bf16*)(KARG(ws) + WS_XB); const float* cw = KARG(conv_w) + (size_t)j * 3 * DM;
    const int chunk = (M + F.NGW - 1) / F.NGW, r0 = gw_ * chunk, r1 = (r0 + chunk < M) ? r0 + chunk : M;
    int row = r0;
    for (; row + 2 <= r1; row += 2) conv_rows<2>(row, lane_, bcv, z, cw);
    for (; row < r1; ++row) conv_rows<1>(row, lane_, bcv, z, cw);
}

template <int R> __device__ __forceinline__ void normrope_rows(int row0, int stride, int lane, unsigned* qkv, const float* ct, const float* st, f32x2 gq, f32x2 gk) {
    const int axis = lane >> 5, half = (lane >> 4) & 1, f0 = 2 * (lane & 15);
    unsigned raw[R][10]; f32x2 cs[R], sn[R];
#pragma unroll
    for (int r = 0; r < R; ++r) { unsigned* base = qkv + (size_t)(row0 + r * stride) * (NQKV / 2);
#pragma unroll
        for (int h = 0; h < 10; ++h) raw[r][h] = base[h * 64 + lane]; }
#pragma unroll
    for (int r = 0; r < R; ++r) { const int row = row0 + r * stride, b = row / TPB, t = row - b * TPB; const bool isctx = t < CTX; const int tl = isctx ? 0 : t - CTX; const int pos = axis ? (tl & 63) : (tl >> 6);
        cs[r] = *(const f32x2*)(ct + pos * 32 + f0); sn[r] = *(const f32x2*)(st + pos * 32 + f0);
        if (isctx) { cs[r] = (f32x2){1.f, 1.f}; sn[r] = (f32x2){0.f, 0.f}; }
        if (half == 0) sn[r] = -sn[r]; }
#pragma unroll
    for (int r = 0; r < R; ++r) { unsigned* base = qkv + (size_t)(row0 + r * stride) * (NQKV / 2);
        float ssq[10];
#pragma unroll
        for (int h = 0; h < 10; ++h) { const float x0 = bflo(raw[r][h]), x1 = bfhi(raw[r][h]); ssq[h] = x0 * x0 + x1 * x1; }
#pragma unroll
        for (int o = 1; o < 64; o <<= 1) {
#pragma unroll
            for (int h = 0; h < 10; ++h) ssq[h] += __shfl_xor(ssq[h], o); }
#pragma unroll
        for (int h = 0; h < 10; ++h) { const float x0 = bflo(raw[r][h]), x1 = bfhi(raw[r][h]);
            const float rstd = 1.0f / sqrtf(ssq[h] * (1.0f / 128.0f) + EPS);
            const f32x2 gg = h < 8 ? gq : gk; const float y0 = x0 * rstd * gg.x, y1 = x1 * rstd * gg.y;
            const float p0 = __shfl_xor(y0, 16), p1 = __shfl_xor(y1, 16);
            const float qs = h < 8 ? 0.12751743f : 1.0f;
            base[h * 64 + lane] = pk2((y0 * cs[r].x + p0 * sn[r].x) * qs, (y1 * cs[r].y + p1 * sn[r].y) * qs); } }
}
__device__ __forceinline__ void normrope_phase(const Args& a, const Ctx& F, int j) {
    PHASE_IDS;
    unsigned* qkv = (unsigned*)(KARG(ws) + WS_BIG); const float* ct = (const float*)(KARG(ws) + WS_ROPE); const float* st = ct + 2048;
    const f32x2 gq = *(const f32x2*)(KARG(attn_q_g) + j * 128 + 2 * lane_), gk = *(const f32x2*)(KARG(attn_k_g) + j * 128 + 2 * lane_);
    int row = gw_;
    for (; row + 3 * F.NGW < M; row += 4 * F.NGW) normrope_rows<4>(row, F.NGW, lane_, qkv, ct, st, gq, gk);
    for (; row < M; row += F.NGW) normrope_rows<1>(row, F.NGW, lane_, qkv, ct, st, gq, gk);
}

__device__ __forceinline__ void attn_phase(const Args& a, const Ctx& F, char* shm, bool ctx_units, int jm) {
    const att::bf16* qkv = (const att::bf16*)(KARG(ws) + WS_BIG); att::bf16* O = (att::bf16*)(KARG(ws) + WS_XB);
    float mraw;
    { PHASE_IDS; const f32x2 gq = *(const f32x2*)(KARG(attn_q_g) + jm * 128 + 2 * lane_), gk = *(const f32x2*)(KARG(attn_k_g) + jm * 128 + 2 * lane_);
      float mq = fmaxf(fabsf(gq.x), fabsf(gq.y)), mk = fmaxf(fabsf(gk.x), fabsf(gk.y));
#pragma unroll
      for (int o_ = 1; o_ < 64; o_ <<= 1) { mq = fmaxf(mq, __shfl_xor(mq, o_)); mk = fmaxf(mk, __shfl_xor(mk, o_)); }
      mraw = 128.0f * mq * mk * 1.0005f; }
    const int c = blockIdx.x;
    for (int i = 0;; ++i) {
        int b, h, qb; bool cu = false;
        if (F.G == 256) {
            if (i < 4) { const int p = 2 * (c & 7) + (i >> 1), w = (i & 1) * 32 + (c >> 3); b = p >> 1; h = (p & 1) * 4 + (w >> 4); qb = w & 15; }
            else if (i == 4 && c < 64 && ctx_units) { cu = true; b = c >> 3; h = c & 7; qb = 0; }
            else break;
        } else {
            const int L = i * F.G + c;
            if (L < 1024) { b = L >> 7; h = (L >> 4) & 7; qb = L & 15; }
            else if (L < 1088 && ctx_units) { cu = true; b = (L - 1024) >> 3; h = L & 7; qb = 0; }
            else break;
        }
        const size_t rowb = (size_t)b * TPB, qrow = cu ? rowb : rowb + CTX + (size_t)qb * 256; const int kvh = h >> 2;
        __syncthreads();
        att::attn_dense_body<att::bf16>(qkv + qrow * NQKV + h * 128, qkv + rowb * NQKV + 1024 + kvh * 128, qkv + rowb * NQKV + 1280 + kvh * 128, O + qrow * DM + h * 128, cu ? CTX : TPB, shm, mraw);
    }
    __syncthreads();
}

__global__ void __launch_bounds__(NTHREADS, 2) fwd_megakernel(Args a) {
    extern __shared__ __attribute__((aligned(16))) unsigned char lds[];
    cg::grid_group grid = cg::this_grid();
    Ctx F;
    F.lds = (LAS unsigned char*)lds; F.G = gridDim.x; F.NGW = F.G * NWAVES; F.NT = F.G * NTHREADS;
#define mod ((const float*)(KARG(ws) + WS_MOD))
#define XN ((bf16*)(KARG(ws) + WS_XN))
#define BIG ((bf16*)(KARG(ws) + WS_BIG))
#define XRES ((float*)(KARG(ws) + WS_XRES))

    if (threadIdx.x < 64) ((LAS unsigned*)(lds + 131072))[threadIdx.x] = 0u;
    __syncthreads();
    (void)xcd_barrier_post((unsigned*)(KARG(ws) + WS_BAR), (volatile LAS unsigned*)(lds + 131072));
#define GSYNC() do { XcdBarrier b_; b_.bar = (unsigned*)(KARG(ws) + WS_BAR); b_.x = (unsigned)__builtin_amdgcn_readfirstlane((int)xb_xcc_id()); b_.st = (volatile LAS unsigned*)(lds + 131072); xcd_barrier(b_); } while (0)
    { PHASE_IDS; float* rss = (float*)(KARG(ws) + WS_RSS); for (int e = gt_; e < 12 * M / 4; e += F.NT) ((f32x4*)rss)[e] = (f32x4){0.f, 0.f, 0.f, 0.f}; }
    p0_weights(a, F);
    p0_ada_partial(a, F);
    p0_rope_table(F);
    grid.sync();
    p1_ada_reduce(a, F);
    GSYNC();
    prep_phase(a, F);
    bias_phase(a, F);
    GSYNC();

    for (int layer = 0; layer < 4; ++layer) {
        const bool is_attn = (layer & 1) != 0; const int jm = layer >> 1;
        for (int sub = 0; sub < 3; ++sub) {
            const int sl = layer * 3 + sub;
            const float* rss = (const float*)(KARG(ws) + WS_RSS) + (size_t)sl * M; const float* sw = (const float*)(KARG(ws) + WS_SW) + (size_t)sl * 9 * NFF2;
            const float* gate = mod + layer * NMOD + (sub * 3 + 2) * 1024;
            const bf16* A2; const bf16* B2; int K2; float coef;
            if (sub != 1) {
                const int fi = layer * 2 + (sub >> 1);
                { pg8::Gemm g{XN, (const bf16*)(KARG(ws) + WS_WFI) + (size_t)fi * NFF2 * DM, M, NFF2, DM}; pg8::StaticOrder S; S.init(M, NFF2, DM, F.G, (int)blockIdx.x, (layer == 3 && sub == 2) ? 1 : 0);
                  pg8::EpiSwiglu E{BIG, FF, rss, sw};
                  pg8::gemm_phase<pg8::EpiSwiglu, pg8::StaticOrder, true, true>(F.lds, g, S, E); }
                GSYNC();
                A2 = BIG; B2 = (const bf16*)(KARG(ws) + WS_WFO) + (size_t)fi * DM * FF; K2 = FF; coef = 0.5f;
            } else {
                const int N1 = is_attn ? NQKV : NCONV;
                { pg8::Gemm g{XN, is_attn ? (const bf16*)(KARG(ws) + WS_WQKV) + (size_t)jm * NQKV * DM : (const bf16*)(KARG(ws) + WS_WCI) + (size_t)jm * NCONV * DM, M, N1, DM};
                  pg8::TailOrder S; S.init(M, N1, DM, F.G, (int)blockIdx.x);
                  if (is_attn) { pg8::EpiBf16N E{BIG, N1, rss, sw}; pg8::gemm_phase<pg8::EpiBf16N, pg8::TailOrder, true, true>(F.lds, g, S, E); }
                  else { pg8::EpiConvIn E{BIG, rss, sw}; pg8::gemm_phase<pg8::EpiConvIn, pg8::TailOrder, true, true>(F.lds, g, S, E); } }
                GSYNC();
                if (is_attn) { normrope_phase(a, F, jm); GSYNC(); attn_phase(a, F, (char*)lds, layer != 3, jm); }
                else conv_phase(a, F, jm);
                GSYNC();
                A2 = (const bf16*)(KARG(ws) + WS_XB); B2 = is_attn ? (const bf16*)(KARG(ws) + WS_WO) + (size_t)jm * DM * DM : (const bf16*)(KARG(ws) + WS_WCO) + (size_t)jm * DM * DM; K2 = DM; coef = 1.0f;
            }
            { pg8::Gemm g{A2, B2, M, DM, K2}; pg8::TailOrder S; S.init(M, DM, K2, F.G, (int)blockIdx.x, (layer == 3 && sub >= 1) ? 1 : 0);
              const int sn = sl + 1, ln = sn / 3, subn = sn - ln * 3; const bool fold = sn < 12;
              unsigned char* wsp = KARG(ws); const int snc = fold ? sn : 0, lnc = fold ? ln : 0;
              float* e_x = (float*)(wsp + WS_XRES); bf16* e_xs = fold ? (bf16*)(wsp + WS_XN) : (bf16*)nullptr; const float* e_gn = KARG(norm_g) + (size_t)snc * 1024;
              const float* e_scn = (const float*)(wsp + WS_MOD) + lnc * NMOD + (subn * 3 + 1) * 1024; float* e_rssn = (float*)(wsp + WS_RSS) + (size_t)snc * M;
              const pg8::EpiRes E{e_x, gate, sub != 1 ? 1 : 0, e_xs, e_gn, e_scn, e_rssn};
              pg8::gemm_phase<pg8::EpiRes, pg8::TailOrder, true, true>(F.lds, g, S, E); }
            GSYNC();
        }
    }
    final_phase(a, F);
}

extern "C" void kernel_launch(void* const* d_in, const int* in_sizes, int n_in, void* d_out, int out_size, void* d_ws, size_t ws_size, hipStream_t stream) {
    static int grid = 0;
    if (grid == 0) {
        if (n_in != 17 || in_sizes[0] != NB * SEQ * DM || out_size != NB * SEQ * DM || ws_size < WS_END) {
            fprintf(stderr, "kernel_launch: shape/workspace mismatch: n_in %d in0 %d out %d ws %zu (need %zu)\n", n_in, n_in > 0 ? in_sizes[0] : -1, out_size, ws_size, (size_t)WS_END); grid = -1; return; }
        int dev = 0, cus = 0, per_cu = 0;
        if (hipGetDevice(&dev) != hipSuccess || hipDeviceGetAttribute(&cus, hipDeviceAttributeMultiprocessorCount, dev) != hipSuccess) { fprintf(stderr, "kernel_launch: device query failed\n"); grid = -1; return; }
        if (hipFuncSetAttribute((const void*)fwd_megakernel, hipFuncAttributeMaxDynamicSharedMemorySize, LDS_BYTES) != hipSuccess) { fprintf(stderr, "kernel_launch: hipFuncSetAttribute failed\n"); grid = -1; return; }
        if (hipOccupancyMaxActiveBlocksPerMultiprocessor(&per_cu, (const void*)fwd_megakernel, NTHREADS, LDS_BYTES) != hipSuccess || per_cu < 1) { fprintf(stderr, "kernel_launch: occupancy query gave %d\n", per_cu); (void)hipGetLastError(); per_cu = 1; }
        grid = cus * per_cu;
    }
    if (grid < 0) return;
    if (hipMemsetAsync((char*)d_ws + WS_BAR, 0, BAR_BYTES, stream) != hipSuccess) { fprintf(stderr, "kernel_launch: hipMemsetAsync failed\n"); return; }
    Args a{};
    a.x = (const float*)d_in[0]; a.c = (const float*)d_in[1]; a.ctx = (const float*)d_in[2]; a.c_ctx = (const float*)d_in[3]; a.ada_w = (const float*)d_in[4]; a.ada_b = (const float*)d_in[5];
    a.norm_g = (const float*)d_in[6]; a.final_g = (const float*)d_in[7]; a.ffn_w_in = (const float*)d_in[8]; a.ffn_w_out = (const float*)d_in[9]; a.conv_w_in = (const float*)d_in[10]; a.conv_w = (const float*)d_in[11];
    a.conv_w_out = (const float*)d_in[12]; a.attn_w_qkv = (const float*)d_in[13]; a.attn_q_g = (const float*)d_in[14]; a.attn_k_g = (const float*)d_in[15]; a.attn_w_o = (const float*)d_in[16];
    a.out = (float*)d_out; a.ws = (unsigned char*)d_ws;
    void* args[] = {&a};
    const hipError_t e = hipLaunchCooperativeKernel((const void*)fwd_megakernel, dim3(grid), dim3(NTHREADS), args, LDS_BYTES, stream);
    if (e != hipSuccess) fprintf(stderr, "kernel_launch: cooperative launch failed: %s (grid %d)\n", hipGetErrorString(e), grid);
}
```

```cpp
#include <hip/hip_runtime.h>
#include <hip/hip_bf16.h>
#include <hip/hip_cooperative_groups.h>
#include <cstdio>
#include <cstdint>
#include <cstddef>
#include <cmath>
namespace cg = cooperative_groups;
__device__ __forceinline__ int opaque_tid() { int t = threadIdx.x; asm volatile("" : "+v"(t)); return t; }
namespace pg8 {
#define PG8_LAS __attribute__((address_space(3)))
typedef unsigned short bf16_t;
typedef short bf16x8 __attribute__((ext_vector_type(8)));
typedef float f32x4 __attribute__((ext_vector_type(4)));
typedef unsigned u32x4 __attribute__((ext_vector_type(4)));
typedef unsigned u32x2 __attribute__((ext_vector_type(2)));
constexpr int BM = 256, BK = 64, HALF = 128, HTB = HALF * BK * 2  , STAGE_BYTES = 8 * HTB, NXCD = 8, WGM = 8;

__host__ __device__ __forceinline__ int lds_byte(int r, int c) { const int st = (r >> 4) * 2 + (c >> 5), rr = r & 15, cc = c & 31, ob = rr * 64 + cc * 2; return st * 1024 + (ob ^ (((ob >> 9) & 1) << 5)); }
__host__ __device__ __forceinline__ void stage_rc(int b, int& R, int& C) { const int st = b / 1024, sb = b % 1024, swz = sb ^ (((sb >> 9) & 1) << 5); R = (st >> 1) * 16 + swz / 64; C = (st & 1) * 32 + (swz % 64) / 2; }
__host__ __device__ __forceinline__ int perm32(int rho) { const int n = rho >> 4, i = rho & 15; return 8 * (i >> 2) + 4 * n + (i & 3); }

struct Unit { int pm, pn, kt0, nkt, sliced, ha, hb; };
struct Gemm { const bf16_t* A; const bf16_t* Bt; int M, N, K; };

struct StaticOrder {
    int nM, nN, nwg, G, c, nkt, lat;
    __host__ __device__ void init(int M, int N, int K, int G_, int c_, int lat_ = 0) { lat = lat_; nM = lat ? 128 : M / BM; nN = N / BM; nwg = nM * nN; G = G_; c = c_; nkt = K / BK; }
    __host__ __device__ bool next(int i, Unit& u) const {
        const long L = (long)i * G + c; if (L >= nwg) return false;
        u.kt0 = 0; u.nkt = nkt; u.sliced = 0; u.ha = -1; u.hb = -1;
        int wgid = (int)L; { const int q = nwg / NXCD, r = nwg % NXCD, xcd = wgid % NXCD, off = wgid / NXCD; wgid = (xcd < r ? xcd * (q + 1) : r * (q + 1) + (xcd - r) * q) + off; }
        const int nig = WGM * nN, gid = wgid / nig, fm = gid * WGM, gsz = (nM - fm) < WGM ? (nM - fm) : WGM;
        u.pm = fm + ((wgid % nig) % gsz); u.pn = (wgid % nig) / gsz; if (lat) u.pm += (u.pm >> 4) + 1; return true;
    }
    __device__ __forceinline__ void a_ready(const Unit&) const {}
    __device__ __forceinline__ void done(const Unit&) const {}
};
struct TailOrder {
    int nM, nN, nwg, G, c, nkt, rounds, left, mode, lat;
    __host__ __device__ void init(int M, int N, int K, int G_, int c_, int lat_ = 0) { lat = lat_; nM = lat ? 128 : M / BM; nN = N / BM; nwg = nM * nN; G = G_; c = c_; nkt = K / BK; rounds = nwg / G; left = nwg - rounds * G; mode = 0;
        if (left > 0) { if (left * 4 <= G) mode = 4; else if (left * 2 <= G) mode = 2; } }
    __host__ __device__ void tile(int wgid, Unit& u) const {
        { const int q = nwg / NXCD, r = nwg % NXCD, xcd = wgid % NXCD, off = wgid / NXCD; wgid = (xcd < r ? xcd * (q + 1) : r * (q + 1) + (xcd - r) * q) + off; }
        const int nig = WGM * nN, gid = wgid / nig, fm = gid * WGM, gsz = (nM - fm) < WGM ? (nM - fm) : WGM;
        u.pm = fm + ((wgid % nig) % gsz); u.pn = (wgid % nig) / gsz; if (lat) u.pm += (u.pm >> 4) + 1; }
    __host__ __device__ bool next(int i, Unit& u) const {
        u.kt0 = 0; u.nkt = nkt; u.sliced = 0; u.ha = -1; u.hb = -1;
        if (mode == 0 || i < rounds) { const long L = (long)i * G + c; if (L >= nwg) return false; tile((int)L, u); return true; }
        if (i > rounds || c >= left * mode) return false;
        int t, piece;
        if ((left & 7) == 0) { const int q = c >> 3, x = c & 7; t = x + 8 * (q / mode); piece = q % mode; } else { t = c / mode; piece = c % mode; }
        tile(rounds * G + t, u); u.ha = piece & 1; u.hb = (mode == 4) ? (piece >> 1) : -1; return true;
    }
    __device__ __forceinline__ void a_ready(const Unit&) const {}
    __device__ __forceinline__ void done(const Unit&) const {}
};
struct SlicedOrder {
    int nM, nN, nwg, G, c, nkt, rounds, left, ns;
    __host__ __device__ void init(int M, int N, int K, int G_, int c_) { nM = M / BM; nN = N / BM; nwg = nM * nN; G = G_; c = c_; nkt = K / BK; rounds = nwg / G; left = nwg - rounds * G; ns = 0;
        if (left > 0 && G % left == 0 && (nkt / 2) >= G / left) ns = G / left; }
    __host__ __device__ void tile(int wgid, Unit& u) const {
        { const int q = nwg / NXCD, r = nwg % NXCD, xcd = wgid % NXCD, off = wgid / NXCD; wgid = (xcd < r ? xcd * (q + 1) : r * (q + 1) + (xcd - r) * q) + off; }
        const int nig = WGM * nN, gid = wgid / nig, fm = gid * WGM, gsz = (nM - fm) < WGM ? (nM - fm) : WGM;
        u.pm = fm + ((wgid % nig) % gsz); u.pn = (wgid % nig) / gsz; }
    __host__ __device__ bool next(int i, Unit& u) const {
        if (ns == 0 || i < rounds) { const long L = (long)i * G + c; if (L >= nwg) return false; tile((int)L, u); u.kt0 = 0; u.nkt = nkt; u.sliced = 0; u.ha = -1; u.hb = -1; return true; }
        if (i > rounds) return false;
        const int sl = c / left, pairs = nkt / 2, base = pairs / ns, rem = pairs % ns;
        tile(rounds * G + c % left, u); u.kt0 = 2 * (sl * base + (sl < rem ? sl : rem)); u.nkt = 2 * (base + (sl < rem ? 1 : 0)); u.sliced = 1; u.ha = -1; u.hb = -1; return true;
    }
    __device__ __forceinline__ void a_ready(const Unit&) const {}
    __device__ __forceinline__ void done(const Unit&) const {}
};

__device__ __forceinline__ unsigned cvt_pk_bf16(float lo, float hi) { unsigned r; asm volatile("v_cvt_pk_bf16_f32 %0, %1, %2" : "=v"(r) : "v"(lo), "v"(hi)); return r; }
typedef float f32x2 __attribute__((ext_vector_type(2)));
__device__ __forceinline__ f32x2 gelu_pk(f32x2 v) {
    const f32x2 av = __builtin_elementwise_abs(v), d = av * 0.2316418882f + 1.0f;
    f32x2 t; t.x = __builtin_amdgcn_rcpf(d.x); t.y = __builtin_amdgcn_rcpf(d.y);
    f32x2 q = t * 0.5307027145f + (-0.7265760135f); q = q * t + 0.7107068705f; q = q * t + (-0.142248368f); q = q * t + 0.127414796f; q = q * t;
    const f32x2 s = (v * v) * (-0.72134752044f);
    f32x2 e; e.x = __builtin_amdgcn_exp2f(s.x); e.y = __builtin_amdgcn_exp2f(s.y);
    const f32x2 m = v * (q * e), r = v - m;
    f32x2 o; o.x = v.x < 0.f ? m.x : r.x; o.y = v.y < 0.f ? m.y : r.y; return o;
}

template <int ACT  > struct EpiBf16 {
    static constexpr bool PERM = true, AFTER_DRAIN = false; static_assert(ACT == 0 || ACT == 1, "EpiBf16: ACT is 0 (none) or 1 (gelu_pk)");
    bf16_t* O; int ldc; const float* bias; int split_cols; size_t split_stride; float scale0;
    __device__ __forceinline__ void operator()(const f32x4 (&acc)[2][2][4][2], const Unit& u, int wr, int wc, int fr, int fq) const {
        const int row0 = u.pm * BM + wr * 64 + fr; int colt = u.pn * BM; bf16_t* base = O;
        float sc = 1.f; if (split_cols) { const int t = colt / split_cols; base += (size_t)t * split_stride; colt -= t * split_cols; if (t == 0) sc = scale0; }
        const int col0 = colt + wc * 32 + 8 * fq, bcol0 = u.pn * BM + wc * 32 + 8 * fq;
        f32x4 bv[2][2];
#pragma unroll
        for (int bj = 0; bj < 2; ++bj)
#pragma unroll
            for (int n = 0; n < 2; ++n) bv[bj][n] = bias ? *(const f32x4*)(bias + bcol0 + bj * HALF + 4 * n) : (f32x4){0.f, 0.f, 0.f, 0.f};
#pragma unroll
        for (int ai = 0; ai < 2; ++ai)
#pragma unroll
            for (int m = 0; m < 4; ++m) { bf16_t* rowp = base + (size_t)(row0 + ai * HALF + m * 16) * ldc + col0;
#pragma unroll
                for (int bj = 0; bj < 2; ++bj) { f32x4 v0 = acc[ai][bj][m][0] + bv[bj][0], v1 = acc[ai][bj][m][1] + bv[bj][1];
                    if (ACT == 1) { f32x2 a = gelu_pk((f32x2){v0[0], v0[1]}), b = gelu_pk((f32x2){v0[2], v0[3]}), c = gelu_pk((f32x2){v1[0], v1[1]}), d = gelu_pk((f32x2){v1[2], v1[3]});
                        v0 = (f32x4){a.x, a.y, b.x, b.y}; v1 = (f32x4){c.x, c.y, d.x, d.y}; }
                    v0 = v0 * sc; v1 = v1 * sc; u32x4 w; w.x = cvt_pk_bf16(v0[0], v0[1]); w.y = cvt_pk_bf16(v0[2], v0[3]); w.z = cvt_pk_bf16(v1[0], v1[1]); w.w = cvt_pk_bf16(v1[2], v1[3]);
                    *(u32x4*)(rowp + bj * HALF) = w; } }
    }
};
__device__ __forceinline__ int mod_index(int pm) { const int b = pm / 17; return (pm - b * 17 == 0) ? 8 : b; }
__device__ __forceinline__ f32x2 swiglu_pk(f32x2 g, f32x2 u) {
    const f32x2 t = g * (-1.4426950408889634f); f32x2 e; e.x = __builtin_amdgcn_exp2f(t.x); e.y = __builtin_amdgcn_exp2f(t.y);
    const f32x2 d = e + 1.0f; f32x2 r; r.x = __builtin_amdgcn_rcpf(d.x); r.y = __builtin_amdgcn_rcpf(d.y);
    return (g * u) * r; }
__device__ __forceinline__ float silu_f(float g) { return g * __builtin_amdgcn_rcpf(1.0f + __builtin_amdgcn_exp2f(-1.4426950408889634f * g)); }
__device__ __forceinline__ float rstd_of(const float* rss, int row) { return 1.0f / sqrtf(rss[row] * (1.0f / 1024.0f) + 1e-6f); }
struct EpiSwiglu {
    static constexpr bool PERM = true, AFTER_DRAIN = false;
    bf16_t* O; int ldc; const float* rss; const float* sw;
    struct Pf { float r[2][4]; f32x4 bg0, bg1, bu0, bu1; };
    __device__ __forceinline__ Pf prefetch(const Unit& u, int wr, int fr) const { Pf p; const int row0 = u.pm * BM + wr * 64 + fr;
        const int lane = threadIdx.x & 63, wc = (threadIdx.x >> 6) & 3, fq = lane >> 4;
#pragma unroll
        for (int ai = 0; ai < 2; ++ai)
#pragma unroll
            for (int m = 0; m < 4; ++m) p.r[ai][m] = rss[row0 + ai * HALF + m * 16];
        const float* bp = sw + (size_t)mod_index(u.pm) * 5632 + u.pn * BM + wc * 32 + 8 * fq;
        p.bg0 = *(const f32x4*)bp; p.bg1 = *(const f32x4*)(bp + 4); p.bu0 = *(const f32x4*)(bp + HALF); p.bu1 = *(const f32x4*)(bp + HALF + 4);
        return p; }
    __device__ __forceinline__ void operator()(const f32x4 (&acc)[2][2][4][2], const Unit& u, int wr, int wc, int fr, int fq, const Pf& pf) const {
        const int row0 = u.pm * BM + wr * 64 + fr, col0 = u.pn * HALF + wc * 32 + 8 * fq;
        const f32x4 bg0 = pf.bg0, bg1 = pf.bg1, bu0 = pf.bu0, bu1 = pf.bu1;
#pragma unroll
        for (int ai = 0; ai < 2; ++ai)
#pragma unroll
            for (int m = 0; m < 4; ++m) { const int row = row0 + ai * HALF + m * 16; bf16_t* rowp = O + (size_t)row * ldc + col0; const float rs = __builtin_amdgcn_rsqf(pf.r[ai][m] * (1.0f / 1024.0f) + 1e-6f);
                const f32x4 g0 = acc[ai][0][m][0] * rs + bg0, g1 = acc[ai][0][m][1] * rs + bg1, u0 = acc[ai][1][m][0] * rs + bu0, u1 = acc[ai][1][m][1] * rs + bu1;
                const f32x2 ha = swiglu_pk((f32x2){g0[0], g0[1]}, (f32x2){u0[0], u0[1]}), hb = swiglu_pk((f32x2){g0[2], g0[3]}, (f32x2){u0[2], u0[3]});
                const f32x2 hc = swiglu_pk((f32x2){g1[0], g1[1]}, (f32x2){u1[0], u1[1]}), hd = swiglu_pk((f32x2){g1[2], g1[3]}, (f32x2){u1[2], u1[3]});
                u32x4 w; w.x = cvt_pk_bf16(ha.x, ha.y); w.y = cvt_pk_bf16(hb.x, hb.y); w.z = cvt_pk_bf16(hc.x, hc.y); w.w = cvt_pk_bf16(hd.x, hd.y);
                *(u32x4*)rowp = w; }
    }
};
struct EpiBf16N {
    static constexpr bool PERM = true, AFTER_DRAIN = false;
    bf16_t* O; int ldc; const float* rss; const float* sw;
    struct Pf { float r[2][4]; };
    __device__ __forceinline__ Pf prefetch(const Unit& u, int wr, int fr) const { Pf p; const int row0 = u.pm * BM + (u.ha > 0 ? HALF : 0) + wr * 64 + fr;
#pragma unroll
        for (int ai = 0; ai < 2; ++ai)
#pragma unroll
            for (int m = 0; m < 4; ++m) p.r[ai][m] = rss[row0 + ai * HALF + m * 16];
        return p; }
    __device__ __forceinline__ void operator()(const f32x4 (&acc)[2][2][4][2], const Unit& u, int wr, int wc, int fr, int fq, const Pf& pf) const {
        const int row0 = u.pm * BM + (u.ha > 0 ? HALF : 0) + wr * 64 + fr, col0 = u.pn * BM + (u.hb > 0 ? HALF : 0) + wc * 32 + 8 * fq; const int na = u.ha < 0 ? 2 : 1, nb = u.hb < 0 ? 2 : 1;
        const float* bp = sw + (size_t)mod_index(u.pm) * 5632 + col0;
        f32x4 bv[2][2];
#pragma unroll
        for (int bj = 0; bj < 2; ++bj)
#pragma unroll
            for (int n = 0; n < 2; ++n) bv[bj][n] = *(const f32x4*)(bp + bj * HALF + 4 * n);
#pragma unroll
        for (int ai = 0; ai < 2; ++ai) if (ai < na)
#pragma unroll
            for (int m = 0; m < 4; ++m) { const int row = row0 + ai * HALF + m * 16; bf16_t* rowp = O + (size_t)row * ldc + col0; const float rs = __builtin_amdgcn_rsqf(pf.r[ai][m] * (1.0f / 1024.0f) + 1e-6f);
#pragma unroll
                for (int bj = 0; bj < 2; ++bj) if (bj < nb) { const f32x4 v0 = acc[ai][bj][m][0] * rs + bv[bj][0], v1 = acc[ai][bj][m][1] * rs + bv[bj][1];
                    u32x4 w; w.x = cvt_pk_bf16(v0[0], v0[1]); w.y = cvt_pk_bf16(v0[2], v0[3]); w.z = cvt_pk_bf16(v1[0], v1[1]); w.w = cvt_pk_bf16(v1[2], v1[3]);
                    *(u32x4*)(rowp + bj * HALF) = w; } }
    }
};
struct EpiConvIn {
    static constexpr bool PERM = true, AFTER_DRAIN = false;
    bf16_t* O; const float* rss; const float* sw;
    struct Pf { float r[2][4]; };
    __device__ __forceinline__ Pf prefetch(const Unit& u, int wr, int fr) const { Pf p; const int row0 = u.pm * BM + (u.ha > 0 ? HALF : 0) + wr * 64 + fr;
#pragma unroll
        for (int ai = 0; ai < 2; ++ai)
#pragma unroll
            for (int m = 0; m < 4; ++m) p.r[ai][m] = rss[row0 + ai * HALF + m * 16];
        return p; }
    __device__ __forceinline__ void operator()(const f32x4 (&acc)[2][2][4][2], const Unit& u, int wr, int wc, int fr, int fq, const Pf& pf) const {
        const int row0 = u.pm * BM + (u.ha > 0 ? HALF : 0) + wr * 64 + fr; const int na = u.ha < 0 ? 2 : 1;
        const float* bp = sw + (size_t)mod_index(u.pm) * 5632 + u.pn * BM + wc * 32 + 8 * fq;
        f32x4 bv[2][2];
#pragma unroll
        for (int bj = 0; bj < 2; ++bj)
#pragma unroll
            for (int n = 0; n < 2; ++n) bv[bj][n] = *(const f32x4*)(bp + bj * HALF + 4 * n);
        const bool paired = u.pn >= 4;
        const int col0 = paired ? 1024 + (u.pn - 4) * HALF + wc * 32 + 8 * fq : u.pn * BM + wc * 32 + 8 * fq;
#pragma unroll
        for (int ai = 0; ai < 2; ++ai) if (ai < na)
#pragma unroll
            for (int m = 0; m < 4; ++m) { const int row = row0 + ai * HALF + m * 16; bf16_t* rowp = O + (size_t)row * 2048 + col0; const float rs = __builtin_amdgcn_rsqf(pf.r[ai][m] * (1.0f / 1024.0f) + 1e-6f);
                const f32x4 a0 = acc[ai][0][m][0] * rs + bv[0][0], a1 = acc[ai][0][m][1] * rs + bv[0][1], c0 = acc[ai][1][m][0] * rs + bv[1][0], c1 = acc[ai][1][m][1] * rs + bv[1][1];
                if (paired) { const f32x4 p0 = a0 * c0, p1 = a1 * c1;
                    u32x4 w; w.x = cvt_pk_bf16(p0[0], p0[1]); w.y = cvt_pk_bf16(p0[2], p0[3]); w.z = cvt_pk_bf16(p1[0], p1[1]); w.w = cvt_pk_bf16(p1[2], p1[3]);
                    *(u32x4*)rowp = w; }
                else { u32x4 w; w.x = cvt_pk_bf16(a0[0], a0[1]); w.y = cvt_pk_bf16(a0[2], a0[3]); w.z = cvt_pk_bf16(a1[0], a1[1]); w.w = cvt_pk_bf16(a1[2], a1[3]);
                    *(u32x4*)rowp = w;
                    u32x4 w2; w2.x = cvt_pk_bf16(c0[0], c0[1]); w2.y = cvt_pk_bf16(c0[2], c0[3]); w2.z = cvt_pk_bf16(c1[0], c1[1]); w2.w = cvt_pk_bf16(c1[2], c1[3]);
                    *(u32x4*)(rowp + HALF) = w2; } }
    }
};
struct EpiRes {
    static constexpr bool PERM = true, AFTER_DRAIN = false;
    float* X; const float* gate; int halfstep; bf16_t* xs; const float* gn; const float* scn; float* rssn;
    struct Pf {};
    __device__ __forceinline__ Pf prefetch(const Unit&, int, int) const { return Pf{}; }
    template <int NA, int NB, bool FOLD>
    __device__ __forceinline__ void body(const f32x4 (&acc)[2][2][4][2], const Unit& u, int wr, int wc, int fr, int fq) const {
        const int mi = mod_index(u.pm); const float coef = halfstep ? 0.5f : 1.0f;
        const float* gv = gate + (size_t)mi * 36864;
        const int col0 = u.pn * BM + wc * 32 + 8 * fq + (u.hb > 0 ? HALF : 0); const int rofs = u.ha > 0 ? HALF : 0;
        f32x4 gg[NB][2], gs[NB][2];
#pragma unroll
        for (int bj = 0; bj < NB; ++bj)
#pragma unroll
            for (int n = 0; n < 2; ++n) { gg[bj][n] = *(const f32x4*)(gv + col0 + bj * HALF + n * 4) * coef;
                if (FOLD) gs[bj][n] = *(const f32x4*)(gn + col0 + bj * HALF + n * 4) * (*(const f32x4*)(scn + (size_t)mi * 36864 + col0 + bj * HALF + n * 4) + 1.0f); }
#pragma unroll
        for (int ai = 0; ai < NA; ++ai) {
#pragma unroll
          for (int mh = 0; mh < 2; ++mh) {
            f32x4 pre[2][NB][2];
#pragma unroll
            for (int mm = 0; mm < 2; ++mm) { const int m = mh * 2 + mm; const float* xp = X + (size_t)(u.pm * BM + rofs + ai * HALF + wr * 64 + m * 16 + fr) * 1024 + col0;
#pragma unroll
                for (int bj = 0; bj < NB; ++bj)
#pragma unroll
                    for (int n = 0; n < 2; ++n) pre[mm][bj][n] = __builtin_nontemporal_load((const f32x4*)(xp + bj * HALF + n * 4)); }
            asm volatile("" ::: "memory");
#pragma unroll
            for (int mm = 0; mm < 2; ++mm) { const int m = mh * 2 + mm; const int row = u.pm * BM + rofs + ai * HALF + wr * 64 + m * 16 + fr; float* xp = X + (size_t)row * 1024 + col0; float ss = 0.f;
#pragma unroll
                for (int bj = 0; bj < NB; ++bj) { float* p = xp + bj * HALF;
                    const f32x4 x0 = pre[mm][bj][0] + gg[bj][0] * acc[ai][bj][m][0], x1 = pre[mm][bj][1] + gg[bj][1] * acc[ai][bj][m][1];
                    __builtin_nontemporal_store(x0, (f32x4*)p); __builtin_nontemporal_store(x1, (f32x4*)(p + 4));
                    if (FOLD) { const f32x4 q = x0 * x0 + x1 * x1; ss += (q[0] + q[1]) + (q[2] + q[3]);
                        const f32x4 o0 = x0 * gs[bj][0], o1 = x1 * gs[bj][1];
                        u32x4 w; w.x = cvt_pk_bf16(o0[0], o0[1]); w.y = cvt_pk_bf16(o0[2], o0[3]); w.z = cvt_pk_bf16(o1[0], o1[1]); w.w = cvt_pk_bf16(o1[2], o1[3]);
                        *(u32x4*)(xs + (size_t)row * 1024 + col0 + bj * HALF) = w; } }
                if (FOLD) { ss += __shfl_xor(ss, 16); ss += __shfl_xor(ss, 32); if (fq == 0) unsafeAtomicAdd(rssn + row, ss); } }
            asm volatile("" ::: "memory"); } }
    }
    __device__ __forceinline__ void operator()(const f32x4 (&acc)[2][2][4][2], const Unit& u, int wr, int wc, int fr, int fq, const Pf&) const {
        const bool fold = xs != nullptr;
        if (u.ha < 0 && u.hb < 0) { if (fold) body<2, 2, true>(acc, u, wr, wc, fr, fq); else body<2, 2, false>(acc, u, wr, wc, fr, fq); }
        else if (u.hb < 0) { if (fold) body<1, 2, true>(acc, u, wr, wc, fr, fq); else body<1, 2, false>(acc, u, wr, wc, fr, fq); }
        else { if (fold) body<1, 1, true>(acc, u, wr, wc, fr, fq); else body<1, 1, false>(acc, u, wr, wc, fr, fq); }
    }
};

template <class Epi, class Sched, bool ALIGN_EPI = false, bool SP2 = false>
__device__ __forceinline__ void gemm_phase(PG8_LAS unsigned char* lds, const Gemm g, const Sched& S, const Epi& E) {
    const int tid = opaque_tid(), wid = __builtin_amdgcn_readfirstlane(tid >> 6), lane = tid & 63, wr = wid >> 2, wc = wid & 3, fr = lane & 15, fq = lane >> 4;
    const int K = g.K;
    unsigned voffA[2], voffB[2];
#pragma unroll
    for (int i = 0; i < 2; ++i) { int R, C; stage_rc(tid * 16 + i * 8192, R, C); const int Rb = Epi::PERM ? ((R & ~31) + perm32(R & 31)) : R;
        voffA[i] = (unsigned)(R * K + C) * 2u; voffB[i] = (unsigned)(Rb * K + C) * 2u; }
    const size_t kstep = (size_t)(BK * 2);
    const size_t hstep = (size_t)HALF * K * 2;
    const size_t tstep = 2 * hstep;
    const unsigned ldsw = (unsigned)wid * 1024u;
    const int aoff = lds_byte(wr * 64 + fr, fq * 8), boff = lds_byte(wc * 32 + fr, fq * 8);
#define PG8_SA(b, h) (((b) * 2 + (h)) * HTB)
#define PG8_SB(b, h) ((4 + (b) * 2 + (h)) * HTB)
#define PG8_STAGE(bufoff, gbase, voff) do { _Pragma("unroll") for (int _i = 0; _i < 2; ++_i) \
        __builtin_amdgcn_global_load_lds((const unsigned*)((const char*)(gbase) + (voff)[_i]), (PG8_LAS unsigned*)(lds + (bufoff) + ldsw + _i * 8192), 16, 0, 0); } while (0)
#define PG8_LDA(dst, b, h) do { _Pragma("unroll") for (int m = 0; m < 4; ++m) _Pragma("unroll") for (int k = 0; k < 2; ++k) dst[m][k] = *(const PG8_LAS bf16x8*)(lds + PG8_SA(b, h) + aoff + m * 2048 + k * 1024); } while (0)
#define PG8_LDB(dst, b, h) do { _Pragma("unroll") for (int n = 0; n < 2; ++n) _Pragma("unroll") for (int k = 0; k < 2; ++k) dst[n][k] = *(const PG8_LAS bf16x8*)(lds + PG8_SB(b, h) + boff + n * 2048 + k * 1024); } while (0)
#define PG8_MMA(ai, bj, At, Bt) do { __builtin_amdgcn_s_setprio(1); _Pragma("unroll") for (int m = 0; m < 4; ++m) _Pragma("unroll") for (int n = 0; n < 2; ++n) _Pragma("unroll") for (int k = 0; k < 2; ++k) \
        acc[ai][bj][m][n] = __builtin_amdgcn_mfma_f32_16x16x32_bf16(Bt[n][k], At[m][k], acc[ai][bj][m][n], 0, 0, 0); __builtin_amdgcn_s_setprio(0); } while (0)
#define PG8_WAIT_V(n) asm volatile("s_waitcnt vmcnt(" #n ")" ::: "memory")
#define PG8_WAIT_L(n) asm volatile("s_waitcnt lgkmcnt(" #n ")" ::: "memory")
#define PG8_BAR __builtin_amdgcn_s_barrier()
#define PG8_SCHED __builtin_amdgcn_sched_barrier(0)
    Unit cur, nxt; int ui = 0;
    if (!S.next(0, cur)) return;
    f32x4 acc[2][2][4][2];
#pragma unroll
    for (int a = 0; a < 2; ++a)
#pragma unroll
        for (int b = 0; b < 2; ++b)
#pragma unroll
            for (int m = 0; m < 4; ++m)
#pragma unroll
                for (int n = 0; n < 2; ++n) acc[a][b][m][n] = (f32x4){0.f, 0.f, 0.f, 0.f};
    bf16x8 At[4][2], B0[2][2], B1[2][2];
    const char* cA = (const char*)g.A + (size_t)cur.pm * tstep + (size_t)cur.kt0 * kstep + (cur.ha > 0 ? hstep : (size_t)0); const char* cB = (const char*)g.Bt + (size_t)cur.pn * tstep + (size_t)cur.kt0 * kstep + (cur.hb > 0 ? hstep : (size_t)0);
    S.a_ready(cur);
    if constexpr (SP2) {
        PG8_STAGE(PG8_SB(0, 0), cB, voffB); PG8_STAGE(PG8_SB(0, 1), cB + hstep, voffB); PG8_STAGE(PG8_SA(0, 0), cA, voffA); PG8_STAGE(PG8_SA(0, 1), cA + hstep, voffA);
        if (wr == 1) PG8_BAR;
        PG8_WAIT_V(2); PG8_BAR;
        PG8_STAGE(PG8_SB(1, 0), cB + kstep, voffB); PG8_STAGE(PG8_SA(1, 0), cA + kstep, voffA); PG8_STAGE(PG8_SB(1, 1), cB + hstep + kstep, voffB);
        PG8_WAIT_V(6); PG8_BAR;
    } else {
        PG8_STAGE(PG8_SB(0, 0), cB, voffB); PG8_STAGE(PG8_SA(0, 0), cA, voffA); PG8_STAGE(PG8_SB(0, 1), cB + hstep, voffB); PG8_STAGE(PG8_SA(0, 1), cA + hstep, voffA);
        if (wr == 1) PG8_BAR;
        PG8_WAIT_V(4); PG8_BAR;
        PG8_STAGE(PG8_SB(1, 0), cB + kstep, voffB); PG8_STAGE(PG8_SA(1, 0), cA + kstep, voffA); PG8_STAGE(PG8_SB(1, 1), cB + hstep + kstep, voffB);
        PG8_WAIT_V(6); PG8_BAR;
    }
    for (;;) {
        const bool has_next = S.next(ui + 1, nxt);
        const char* nA = has_next ? (const char*)g.A + (size_t)nxt.pm * tstep + (size_t)nxt.kt0 * kstep + (nxt.ha > 0 ? hstep : (size_t)0) : cA; const char* nB = has_next ? (const char*)g.Bt + (size_t)nxt.pn * tstep + (size_t)nxt.kt0 * kstep + (nxt.hb > 0 ? hstep : (size_t)0) : cB;
        const typename Epi::Pf pf = E.prefetch(cur, wr, fr);
        const int nt = cur.nkt; const bool doA1 = cur.ha < 0, doB1 = cur.hb < 0;
        for (int t = 0; t < nt; t += 2) {
            const bool last = (t == nt - 2);
            const char* a1 = cA + (size_t)(t + 1) * kstep;
            const char* a2 = last ? nA : cA + (size_t)(t + 2) * kstep; const char* b2 = last ? nB : cB + (size_t)(t + 2) * kstep;
            const char* a3 = a2 + kstep; const char* b3 = b2 + kstep;
            if (last && has_next) S.a_ready(nxt);
            if constexpr (SP2) {
            PG8_LDB(B0, 0, 0); PG8_LDB(B1, 0, 1); PG8_SCHED; PG8_LDA(At, 0, 0); PG8_STAGE(PG8_SA(1, 1), a1 + hstep, voffA);
            PG8_WAIT_V(8); PG8_WAIT_L(0); PG8_BAR; PG8_MMA(0, 0, At, B0); if (doB1) PG8_MMA(0, 1, At, B1); PG8_BAR; PG8_SCHED;
            PG8_LDA(At, 0, 1); PG8_STAGE(PG8_SB(0, 0), b2, voffB); PG8_STAGE(PG8_SB(0, 1), b2 + hstep, voffB); PG8_STAGE(PG8_SA(0, 0), a2, voffA);
            PG8_WAIT_V(8); PG8_WAIT_L(0); PG8_BAR; if (doA1) { PG8_MMA(1, 0, At, B0); if (doB1) PG8_MMA(1, 1, At, B1); } PG8_BAR; PG8_SCHED;
            PG8_LDB(B0, 1, 0); PG8_LDB(B1, 1, 1); PG8_SCHED; PG8_LDA(At, 1, 0); PG8_STAGE(PG8_SA(0, 1), a2 + hstep, voffA);
            PG8_WAIT_V(8); PG8_WAIT_L(0); PG8_BAR; PG8_MMA(0, 0, At, B0); if (doB1) PG8_MMA(0, 1, At, B1); PG8_BAR; PG8_SCHED;
            PG8_LDA(At, 1, 1); PG8_STAGE(PG8_SB(1, 0), b3, voffB); PG8_STAGE(PG8_SB(1, 1), b3 + hstep, voffB); PG8_STAGE(PG8_SA(1, 0), a3, voffA);
            PG8_WAIT_V(8); PG8_WAIT_L(0); PG8_BAR; if (doA1) { PG8_MMA(1, 0, At, B0); if (doB1) PG8_MMA(1, 1, At, B1); } PG8_BAR; PG8_SCHED;
            } else {
            PG8_LDB(B0, 0, 0); PG8_SCHED; PG8_LDA(At, 0, 0); PG8_STAGE(PG8_SA(1, 1), a1 + hstep, voffA);
            PG8_WAIT_L(8); PG8_BAR; PG8_WAIT_L(0); PG8_MMA(0, 0, At, B0); PG8_BAR; PG8_SCHED;
            PG8_LDB(B1, 0, 1); PG8_STAGE(PG8_SB(0, 0), b2, voffB);
            PG8_BAR; PG8_WAIT_L(0); PG8_MMA(0, 1, At, B1); PG8_BAR;
            PG8_LDA(At, 0, 1); PG8_STAGE(PG8_SA(0, 0), a2, voffA);
            PG8_BAR; PG8_WAIT_L(0); PG8_MMA(1, 0, At, B0); PG8_BAR; PG8_SCHED;
            PG8_STAGE(PG8_SB(0, 1), b2 + hstep, voffB);
            PG8_WAIT_V(6); PG8_BAR; PG8_MMA(1, 1, At, B1); PG8_BAR;
            PG8_LDB(B0, 1, 0); PG8_SCHED; PG8_LDA(At, 1, 0); PG8_STAGE(PG8_SA(0, 1), a2 + hstep, voffA);
            PG8_WAIT_L(8); PG8_BAR; PG8_WAIT_L(0); PG8_MMA(0, 0, At, B0); PG8_BAR; PG8_SCHED;
            PG8_LDB(B1, 1, 1); PG8_STAGE(PG8_SB(1, 0), b3, voffB);
            PG8_BAR; PG8_WAIT_L(0); PG8_MMA(0, 1, At, B1); PG8_BAR;
            PG8_LDA(At, 1, 1); PG8_STAGE(PG8_SA(1, 0), a3, voffA);
            PG8_BAR; PG8_WAIT_L(0); PG8_MMA(1, 0, At, B0); PG8_BAR; PG8_SCHED;
            PG8_STAGE(PG8_SB(1, 1), b3 + hstep, voffB);
            PG8_WAIT_V(6); PG8_BAR; PG8_MMA(1, 1, At, B1); PG8_BAR;
            }
        }
        if constexpr (ALIGN_EPI) { if (wr == 0) PG8_BAR; }
        if constexpr (!Epi::AFTER_DRAIN) { E(acc, cur, wr, wc, fr, fq, pf); S.done(cur); }
        if (!has_next) break;
#pragma unroll
        for (int a = 0; a < 2; ++a)
#pragma unroll
            for (int b = 0; b < 2; ++b)
#pragma unroll
                for (int m = 0; m < 4; ++m)
#pragma unroll
                    for (int n = 0; n < 2; ++n) acc[a][b][m][n] = (f32x4){0.f, 0.f, 0.f, 0.f};
        cur = nxt; cA = nA; cB = nB; ++ui;
        if constexpr (ALIGN_EPI) { if (wr == 1) PG8_BAR; }
    }
    PG8_WAIT_V(0);
    if constexpr (!ALIGN_EPI) { if (wr == 0) PG8_BAR; }
    PG8_BAR;
    if constexpr (Epi::AFTER_DRAIN) { E.fused(acc, cur, wr, wc, fr, fq, lds, wid, lane); S.done(cur); }
#undef PG8_SA
#undef PG8_SB
#undef PG8_STAGE
#undef PG8_LDA
#undef PG8_LDB
#undef PG8_MMA
#undef PG8_WAIT_V
#undef PG8_WAIT_L
#undef PG8_BAR
#undef PG8_SCHED
}
}
namespace att {
using bf16 = __hip_bfloat16;
constexpr int   D = 128, NW = 8, QBLK = 32, KVBLK = 64;
constexpr float SCALE = 0.088388347648318440f;
constexpr float THR = 8.f;
constexpr int SDEPTH = 2;
constexpr int LDQ = 1536, LDK = 1536, LDO = 1024;
constexpr size_t SHM_V = KVBLK * D * 2, SHM_K = KVBLK * D * 2, SHM_ATTN = 3 * SHM_V + 3 * SHM_K + NW * 64 * 4;

using bf16x8 = __attribute__((ext_vector_type(8))) short;
using s16x4  = __attribute__((ext_vector_type(4))) short;
using f32x16 = __attribute__((ext_vector_type(16))) float;
using f32x8  = __attribute__((ext_vector_type(8))) float;
using u32x4  = __attribute__((ext_vector_type(4))) unsigned;
#define KSWZ(row, colB) ((row) * 256 + ((colB) ^ (((row) & 7) << 4)))
#define SBAR() __builtin_amdgcn_sched_barrier(0)
__device__ __forceinline__ int crow(int r, int hi) { return (r & 3) + 8 * (r >> 2) + 4 * hi; }
__device__ __forceinline__ unsigned cvtpk(float lo, float hi) {
  unsigned r; asm volatile("v_cvt_pk_bf16_f32 %0, %1, %2" : "=v"(r) : "v"(lo), "v"(hi)); return r;
}
template <typename TIn> struct Stage;
template <> struct Stage<bf16>  { using T = bf16x8;
  __device__ static __forceinline__ T ld8(const bf16* p) { return *reinterpret_cast<const bf16x8*>(p); }
  __device__ static __forceinline__ bf16x8 tobf(T x) { return x; } };
template <> struct Stage<float> { using T = f32x8;
  __device__ static __forceinline__ T ld8(const float* p) { return *reinterpret_cast<const f32x8*>(p); }
  __device__ static __forceinline__ bf16x8 tobf(T x) {
    u32x4 w = {cvtpk(x[0], x[1]), cvtpk(x[2], x[3]), cvtpk(x[4], x[5]), cvtpk(x[6], x[7])}; return *reinterpret_cast<bf16x8*>(&w); } };

__device__ __forceinline__ void partialSM(f32x16& p0, f32x16& p1, float& m_reg, float& mn, float& alpha) {
  constexpr float C = SCALE * 1.4426950408889634f;
  float pmax = p0[0]; for (int r = 1; r < 16; ++r) pmax = fmaxf(pmax, p0[r]); for (int r = 0; r < 16; ++r) pmax = fmaxf(pmax, p1[r]);
  { auto rr = __builtin_amdgcn_permlane32_swap(__float_as_uint(pmax), __float_as_uint(pmax), false, false);
    pmax = fmaxf(__uint_as_float(rr[0]), __uint_as_float(rr[1])); }
  if (__builtin_expect(__all(pmax - m_reg <= THR / SCALE), 1)) { mn = m_reg; alpha = 1.f; }
  else { mn = fmaxf(m_reg, pmax); alpha = __builtin_amdgcn_exp2f((m_reg - mn) * C); m_reg = mn; }
  float mnC = -mn * C;
  for (int r = 0; r < 16; ++r) p0[r] = fmaf(p0[r], C, mnC); for (int r = 0; r < 16; ++r) p1[r] = fmaf(p1[r], C, mnC);
  for (int r = 0; r < 16; ++r) p0[r] = __builtin_amdgcn_exp2f(p0[r]);
}
__device__ __forceinline__ void partialSM_fixed(f32x16& p0, f32x16& p1, float mnC) {
  constexpr float C = SCALE * 1.4426950408889634f;
  (void)mnC; (void)p1;
  for (int r = 0; r < 16; ++r) p0[r] = __builtin_amdgcn_exp2f(p0[r]);
}
__device__ __forceinline__ void finishSM(f32x16& p0, f32x16& p1, float alpha, f32x16& lacc, bf16x8& pa0, bf16x8& pa1, bf16x8& pa2, bf16x8& pa3) {
  for (int r = 0; r < 16; ++r) p1[r] = __builtin_amdgcn_exp2f(p1[r]);
  (void)alpha;
#define LADD8(P, B) asm("s_nop 1\n\tv_add_f32 %0, %0, %8\n\tv_add_f32 %1, %1, %9\n\tv_add_f32 %2, %2, %10\n\tv_add_f32 %3, %3, %11\n\tv_add_f32 %4, %4, %12\n\tv_add_f32 %5, %5, %13\n\tv_add_f32 %6, %6, %14\n\tv_add_f32 %7, %7, %15" \
    : "+v"(lacc[B + 0]), "+v"(lacc[B + 1]), "+v"(lacc[B + 2]), "+v"(lacc[B + 3]), "+v"(lacc[B + 4]), "+v"(lacc[B + 5]), "+v"(lacc[B + 6]), "+v"(lacc[B + 7]) \
    : "v"(P[B + 0]), "v"(P[B + 1]), "v"(P[B + 2]), "v"(P[B + 3]), "v"(P[B + 4]), "v"(P[B + 5]), "v"(P[B + 6]), "v"(P[B + 7]))
  LADD8(p0, 0); LADD8(p0, 8); LADD8(p1, 0); LADD8(p1, 8);
#undef LADD8
#define PK4(P, BASE, OUT) do { unsigned a0 = cvtpk(P[BASE + 0], P[BASE + 1]), a1 = cvtpk(P[BASE + 2], P[BASE + 3]);   \
    unsigned b0 = cvtpk(P[BASE + 4], P[BASE + 5]), b1 = cvtpk(P[BASE + 6], P[BASE + 7]);                              \
    auto r0 = __builtin_amdgcn_permlane32_swap(a0, b0, false, false); auto r1 = __builtin_amdgcn_permlane32_swap(a1, b1, false, false); \
    u32x4 w = {r0[0], r1[0], r0[1], r1[1]}; OUT = *reinterpret_cast<bf16x8*>(&w); } while (0)
  PK4(p0, 0, pa0); PK4(p0, 8, pa1); PK4(p1, 0, pa2); PK4(p1, 8, pa3);
#undef PK4
}
__device__ __forceinline__ void qkt(f32x16& p0, f32x16& p1, const bf16* Ks, const bf16x8* qr, int r32, int hi, const f32x16& iv) {
#pragma unroll
  for (int d0 = 0; d0 < 8; ++d0) { int cb = (d0 * 16 + hi * 8) * 2;
    bf16x8 b0 = *reinterpret_cast<const bf16x8*>((const char*)Ks + KSWZ(r32, cb));
    bf16x8 b1 = *reinterpret_cast<const bf16x8*>((const char*)Ks + KSWZ(32 + r32, cb));
    p0 = __builtin_amdgcn_mfma_f32_32x32x16_bf16(b0, qr[d0], d0 == 0 ? iv : p0, 0, 0, 0);
    p1 = __builtin_amdgcn_mfma_f32_32x32x16_bf16(b1, qr[d0], d0 == 0 ? iv : p1, 0, 0, 0); }
}
__device__ __forceinline__ int v_st(int k, int c) { const int kk = (k & ~0xC) | ((k & 4) << 1) | ((k & 8) >> 1); return ((kk >> 3) * 4 + (c >> 5)) * 512 + ((kk & 7) * 32 + (c & 31)) * 2; }
__device__ __forceinline__ int v_rd_base(int lane) { return ((lane & 3) << 3) | (((lane >> 2) & 3) << 6) | (((lane >> 4) & 1) << 5) | (((lane >> 5) & 1) << 8); }
constexpr int v_rd_off(int d0, int ks, int half) { return d0 * 512 + ks * 4096 + half * 2048; }
template <int OFF> __device__ __forceinline__ s16x4 tr_read(int vb) {
  s16x4 r; asm volatile("ds_read_b64_tr_b16 %0, %1 offset:%2" : "=&v"(r) : "v"(vb), "i"(OFF) : "memory"); return r;
}
template <int D0> __device__ __forceinline__ void pv_one(f32x16& od, int vb, bf16x8 pa0, bf16x8 pa1, bf16x8 pa2, bf16x8 pa3) {
  const s16x4 l0 = tr_read<v_rd_off(D0, 0, 0)>(vb), h0 = tr_read<v_rd_off(D0, 0, 1)>(vb), l1 = tr_read<v_rd_off(D0, 1, 0)>(vb), h1 = tr_read<v_rd_off(D0, 1, 1)>(vb);
  const s16x4 l2 = tr_read<v_rd_off(D0, 2, 0)>(vb), h2 = tr_read<v_rd_off(D0, 2, 1)>(vb), l3 = tr_read<v_rd_off(D0, 3, 0)>(vb), h3 = tr_read<v_rd_off(D0, 3, 1)>(vb);
  asm volatile("s_waitcnt lgkmcnt(0)" ::: "memory"); SBAR();
#define PK(L, H) (bf16x8){L[0], L[1], L[2], L[3], H[0], H[1], H[2], H[3]}
  od = __builtin_amdgcn_mfma_f32_32x32x16_bf16(pa0, PK(l0, h0), od, 0, 0, 0);
  od = __builtin_amdgcn_mfma_f32_32x32x16_bf16(pa1, PK(l1, h1), od, 0, 0, 0);
  od = __builtin_amdgcn_mfma_f32_32x32x16_bf16(pa2, PK(l2, h2), od, 0, 0, 0);
  od = __builtin_amdgcn_mfma_f32_32x32x16_bf16(pa3, PK(l3, h3), od, 0, 0, 0);
#undef PK
}
__device__ __forceinline__ void pv_d0(f32x16* o, int vb, bf16x8 pa0, bf16x8 pa1, bf16x8 pa2, bf16x8 pa3) {
  pv_one<0>(o[0], vb, pa0, pa1, pa2, pa3); pv_one<1>(o[1], vb, pa0, pa1, pa2, pa3); pv_one<2>(o[2], vb, pa0, pa1, pa2, pa3); pv_one<3>(o[3], vb, pa0, pa1, pa2, pa3);
}

template <typename TQ>
__device__ __forceinline__ void attn_dense_body(const TQ* __restrict__ Qb, const bf16* __restrict__ Kh, const bf16* __restrict__ Vh,
                                                bf16* __restrict__ Ob, int seq, char* lds, float mraw) {
  using SQ = Stage<TQ>;
  const float mnC = -mraw * (SCALE * 1.4426950408889634f);
  f32x16 iv; for (int r = 0; r < 16; ++r) iv[r] = mnC;
  typedef __attribute__((address_space(3))) unsigned lds_u32;
  const int tid = opaque_tid(), wid = __builtin_amdgcn_readfirstlane(tid >> 6), lane = tid & 63, r32 = lane & 31, hi = lane >> 5;
  const unsigned ldsb = (unsigned)(uintptr_t)lds;
  bf16* V_lds = (bf16*)lds; bf16* K_lds = (bf16*)(lds + 3 * SHM_V);
  float* ws = (float*)(lds + 3 * SHM_V + 3 * SHM_K) + wid * 64; float* li_l = ws; float* al_l = ws + 32;
  f32x16 lacc = {}; f32x16 o[4] = {}; bf16x8 qr[8];
  const TQ* Qw = Qb + (long)(wid * QBLK + r32) * LDQ + hi * 8;
#pragma unroll
  for (int d0 = 0; d0 < 8; ++d0) qr[d0] = SQ::tobf(SQ::ld8(Qw + d0 * 16));
  long ksrc[2], vsrc[2];
#pragma unroll
  for (int t = 0; t < 2; ++t) { const int q = (wid * 2 + t) * 64 + lane;
    { const int row = q >> 4, c = (q & 15) ^ (row & 7); ksrc[t] = (long)row * LDK + c * 8; }
    { const int off = q * 16, sub = off >> 9, kk = (sub >> 2) * 8 + ((off & 511) >> 6), cc = (sub & 3) * 32 + ((off & 63) >> 1);
      const int k = (kk & ~0xC) | ((kk & 4) << 1) | ((kk & 8) >> 1); vsrc[t] = (long)k * LDK + cc; } }
  const int vb0 = (int)ldsb + v_rd_base(lane);
#define DMA_TILE(tile, buf) do { const bf16* kp_ = Kh + (long)(tile) * KVBLK * LDK; const bf16* vp_ = Vh + (long)(tile) * KVBLK * LDK; _Pragma("unroll") for (int t_ = 0; t_ < 2; ++t_) { \
      __builtin_amdgcn_global_load_lds((const unsigned*)(kp_ + ksrc[t_]), (lds_u32*)(size_t)(ldsb + 3 * (unsigned)SHM_V + (unsigned)(buf) * (unsigned)SHM_K + (unsigned)(wid * 2 + t_) * 1024u), 16, 0, 0); \
      __builtin_amdgcn_global_load_lds((const unsigned*)(vp_ + vsrc[t_]), (lds_u32*)(size_t)(ldsb + (unsigned)(buf) * (unsigned)SHM_V + (unsigned)(wid * 2 + t_) * 1024u), 16, 0, 0); } } while (0)
#define KBUF(b) ((bf16*)((char*)K_lds + (b) * SHM_K))
#define VBUF(b) (vb0 + (b) * (int)SHM_V)
#define LANDED_BAR() do { asm volatile("s_waitcnt vmcnt(0)" ::: "memory"); __syncthreads(); } while (0)
#define RESC(a) do { if (__any((a) < 1.f)) { if (hi == 0) al_l[r32] = (a); asm volatile("s_waitcnt lgkmcnt(0)" ::: "memory"); \
    for (int d = 0; d < 4; ++d) for (int r = 0; r < 16; ++r) o[d][r] *= al_l[crow(r, hi)]; } } while (0)
  f32x16 pA0, pA1, pB0, pB1; bf16x8 pa0, pa1, pa2, pa3; const int NT = seq / KVBLK;
  DMA_TILE(0, 0); DMA_TILE(1, 1); DMA_TILE(2, 2);
  asm volatile("s_waitcnt vmcnt(8)" ::: "memory"); __syncthreads();
  qkt(pA0, pA1, KBUF(0), qr, r32, hi, iv); partialSM_fixed(pA0, pA1, mnC);
  asm volatile("s_waitcnt vmcnt(4)" ::: "memory"); __syncthreads();
  int bprev = 0, bcur = 1, bnext = 2;
  for (int j = 1; j + 1 < NT; j += 2) {
    SBAR(); qkt(pB0, pB1, KBUF(bcur), qr, r32, hi, iv);
    finishSM(pA0, pA1, 1.f, lacc, pa0, pa1, pa2, pa3); SBAR();
    pv_d0(o, VBUF(bprev), pa0, pa1, pa2, pa3); partialSM_fixed(pB0, pB1, mnC);
    LANDED_BAR();
    if (j + 2 < NT) DMA_TILE(j + 2, bprev);
    SBAR(); qkt(pA0, pA1, KBUF(bnext), qr, r32, hi, iv);
    finishSM(pB0, pB1, 1.f, lacc, pa0, pa1, pa2, pa3); SBAR();
    pv_d0(o, VBUF(bcur), pa0, pa1, pa2, pa3); partialSM_fixed(pA0, pA1, mnC);
    LANDED_BAR();
    if (j + 3 < NT) DMA_TILE(j + 3, bcur);
    { const int t0_ = bprev; bprev = bnext; bnext = bcur; bcur = t0_; }
  }
  SBAR(); qkt(pB0, pB1, KBUF(bcur), qr, r32, hi, iv);
  finishSM(pA0, pA1, 1.f, lacc, pa0, pa1, pa2, pa3); SBAR();
  pv_d0(o, VBUF(bprev), pa0, pa1, pa2, pa3); partialSM_fixed(pB0, pB1, mnC);
  finishSM(pB0, pB1, 1.f, lacc, pa0, pa1, pa2, pa3); SBAR();
  pv_d0(o, VBUF(bcur), pa0, pa1, pa2, pa3);
  float l_reg = 0; for (int r = 0; r < 16; ++r) l_reg += lacc[r];
  { auto rr = __builtin_amdgcn_permlane32_swap(__float_as_uint(l_reg), __float_as_uint(l_reg), false, false); l_reg = __uint_as_float(rr[0]) + __uint_as_float(rr[1]); }
  if (hi == 0) li_l[r32] = l_reg; asm volatile("s_waitcnt lgkmcnt(0)" ::: "memory");
  float rli[16];
#pragma unroll
  for (int r = 0; r < 16; ++r) rli[r] = __builtin_amdgcn_rcpf(li_l[crow(r, hi)]);
  bf16* Ow = Ob + (long)(wid * QBLK) * LDO;
#pragma unroll
  for (int r = 0; r < 16; ++r) { int orow = crow(r, hi);
#pragma unroll
    for (int d0 = 0; d0 < 4; ++d0) { const float v = o[d0][r] * rli[r]; const float nb = __shfl_xor(v, 1);
      if (!(r32 & 1)) *reinterpret_cast<unsigned*>(Ow + (long)orow * LDO + d0 * 32 + r32) = cvtpk(v, nb); } }
#undef DMA_TILE
#undef KBUF
#undef VBUF
#undef LANDED_BAR
#undef RESC
}
}

constexpr int NB = 8, SEQ = 4096, CTX = 256, DM = 1024, FF = 2816, NFF2 = 2 * FF, NQKV = 1536, NCONV = 3072;
constexpr int TPB = CTX + SEQ;
constexpr int M = NB * TPB;
constexpr int NMOD = 9 * 1024;
constexpr int MODW = 4 * NMOD;
constexpr int KSPLIT = 8;
constexpr int NWAVES = 8, NTHREADS = 512;
constexpr float EPS = 1e-6f;
constexpr size_t al256(size_t x) { return (x + 255) / 256 * 256; }
constexpr size_t WS_BAR = 0, BAR_BYTES = 16384;
constexpr size_t WS_MOD = BAR_BYTES;
constexpr size_t WS_ROPE = al256(WS_MOD + (size_t)9 * MODW * 4);
constexpr size_t WS_PART = al256(WS_ROPE + 2 * 64 * 32 * 4);
constexpr size_t WS_WFI = al256(WS_PART + (size_t)KSPLIT * 9 * MODW * 4);
constexpr size_t WS_WFO = al256(WS_WFI + (size_t)8 * NFF2 * DM * 2);
constexpr size_t WS_WCI = al256(WS_WFO + (size_t)8 * DM * FF * 2);
constexpr size_t WS_WCO = al256(WS_WCI + (size_t)2 * NCONV * DM * 2);
constexpr size_t WS_WQKV = al256(WS_WCO + (size_t)2 * DM * DM * 2);
constexpr size_t WS_WO = al256(WS_WQKV + (size_t)2 * NQKV * DM * 2);
constexpr size_t WS_XRES = al256(WS_WO + (size_t)2 * DM * DM * 2);
constexpr size_t WS_XN = al256(WS_XRES + (size_t)M * DM * 4);
constexpr size_t WS_BIG = al256(WS_XN + (size_t)M * DM * 2);
constexpr size_t WS_XB = al256(WS_BIG + (size_t)M * NCONV * 2);
constexpr size_t WS_RSS = al256(WS_XB + (size_t)M * DM * 2);
constexpr size_t WS_SW = al256(WS_RSS + (size_t)12 * M * 4);
constexpr size_t WS_END = al256(WS_SW + (size_t)12 * 9 * NFF2 * 4);
constexpr int LDS_BYTES = 131072 + 1024;

typedef unsigned short bf16;
typedef unsigned v4u __attribute__((ext_vector_type(4)));
typedef unsigned v2u __attribute__((ext_vector_type(2)));
typedef float f32x4 __attribute__((ext_vector_type(4)));
typedef float f32x2 __attribute__((ext_vector_type(2)));
#define LAS __attribute__((address_space(3)))
#define LDS_WAIT() asm volatile("s_waitcnt lgkmcnt(0)" ::: "memory")
__device__ __forceinline__ unsigned pk2(float lo, float hi) { return pg8::cvt_pk_bf16(lo, hi); }
__device__ __forceinline__ float bflo(unsigned w) { return __uint_as_float(w << 16); }
__device__ __forceinline__ float bfhi(unsigned w) { return __uint_as_float(w & 0xffff0000u); }
__device__ __forceinline__ float wave_sum(float v) {
#pragma unroll
    for (int o = 1; o < 64; o <<= 1) v += __shfl_xor(v, o);
    return v;
}

#define XB_TMO      128
#define XB_XCNT(j)  (256  + 64 * (j))
#define XB_XSUB(j)  (1280 + 64 * (j))
#define XB_XGEN(j)  (2304 + 64 * (j))
#define XB_TOP      3328
#define XB_TOPGEN   3392
#define XCD_BAR_WORDS 3456
#define XB_SPIN_CAP (1u << 18)

__device__ __forceinline__ unsigned xb_ld(unsigned* p)              { return __hip_atomic_load(p, __ATOMIC_RELAXED, __HIP_MEMORY_SCOPE_AGENT); }
__device__ __forceinline__ unsigned xb_add(unsigned* p, unsigned v) { return __hip_atomic_fetch_add(p, v, __ATOMIC_RELAXED, __HIP_MEMORY_SCOPE_AGENT); }
__device__ __forceinline__ unsigned xb_xcc_id() { return (unsigned)__builtin_amdgcn_s_getreg((3 << 11) | 20) & 0xFu; }
#define XB_SPIN(cond, bar) do { unsigned _sp = 0; while (cond) { __builtin_amdgcn_s_sleep(1); \
    if ((++_sp & 255u) == 0u) { if (xb_ld(&(bar)[XB_TMO])) break; if (_sp > XB_SPIN_CAP) { atomicAdd(&(bar)[XB_TMO], 1u); break; } } } } while (0)

struct XcdBarrier {
    unsigned* bar; unsigned x;
    volatile LAS unsigned* st;
};

__device__ __forceinline__ XcdBarrier xcd_barrier_post(unsigned* bar, volatile LAS unsigned* st) {
    XcdBarrier b; b.bar = bar; b.x = xb_xcc_id(); b.st = st;
    if (threadIdx.x == 0) (void)xb_add(&bar[XB_XCNT(b.x)], 1u);
    return b;
}
__device__ __forceinline__ void xcd_barrier_complete(unsigned* bar, unsigned x, unsigned& nloc, unsigned& nx) {
    const unsigned G = gridDim.x * gridDim.y * gridDim.z;
    unsigned sum, cnt, mine, sp = 0u;
    for (;;) {
        sum = 0u; cnt = 0u; mine = 0u;
#pragma unroll
        for (unsigned j = 0; j < 16; ++j) { const unsigned c = xb_ld(&bar[XB_XCNT(j)]); sum += c; cnt += (c > 0u) ? 1u : 0u; mine = (j == x) ? c : mine; }
        if (sum == G) break;
        __builtin_amdgcn_s_sleep(1);
        if ((++sp & 255u) == 0u) { if (xb_ld(&bar[XB_TMO])) break; if (sp > XB_SPIN_CAP) { atomicAdd(&bar[XB_TMO], 1u); break; } }
    }
    nloc = mine > 0u ? mine : 1u; nx = cnt > 0u ? cnt : 1u;
}

__device__ __forceinline__ void xcd_barrier(const XcdBarrier& b) {
    asm volatile("s_waitcnt vmcnt(0)" ::: "memory");
    __syncthreads();
    if (threadIdx.x == 0) {
        unsigned* bar = b.bar;
        __builtin_amdgcn_s_waitcnt(0);
        unsigned nloc = b.st[0], nx = b.st[1];
        if (nloc == 0u) { xcd_barrier_complete(bar, b.x, nloc, nx); b.st[0] = nloc; b.st[1] = nx; }
        const unsigned old = xb_add(&bar[XB_XSUB(b.x)], 1u);
        const unsigned gen = old / nloc;
        if (old + 1u == (gen + 1u) * nloc) {
            __builtin_amdgcn_fence(__ATOMIC_RELEASE, "agent");
            asm volatile("s_waitcnt vmcnt(0)" ::: "memory");
            const unsigned og = xb_add(&bar[XB_TOP], 1u);
            const unsigned tg = og / nx;
            if (og + 1u == (tg + 1u) * nx) xb_add(&bar[XB_TOPGEN], 1u);
            else XB_SPIN(xb_ld(&bar[XB_TOPGEN]) == tg, bar);
            __builtin_amdgcn_fence(__ATOMIC_ACQUIRE, "agent");
            xb_add(&bar[XB_XGEN(b.x)], 1u);
            asm volatile("s_waitcnt vmcnt(0)" ::: "memory");
        } else {
            XB_SPIN(xb_ld(&bar[XB_XGEN(b.x)]) == gen, bar);
            __builtin_amdgcn_fence(__ATOMIC_ACQUIRE, "agent");
            asm volatile("s_waitcnt vmcnt(0)" ::: "memory");
        }
    }
    __syncthreads();
}

struct Args {
    const float *x, *c, *ctx, *c_ctx, *ada_w, *ada_b, *norm_g, *final_g, *ffn_w_in, *ffn_w_out, *conv_w_in, *conv_w, *conv_w_out, *attn_w_qkv, *attn_q_g, *attn_k_g, *attn_w_o;
    float* out; unsigned char* ws;
};
__device__ __forceinline__ const void* karg_ptr(size_t off) { const char __attribute__((address_space(4)))* kp = (const char __attribute__((address_space(4)))*)__builtin_amdgcn_kernarg_segment_ptr(); asm volatile("" : "+s"(kp)); return *(const void* const __attribute__((address_space(4)))*)(kp + off); }
#define KARG(name) ((decltype(Args::name))karg_ptr(offsetof(Args, name)))

__device__ __forceinline__ void transpose_item(const float* W, int K, int N, bf16* WT, int mode, LAS float* scr, int item, int lane) {
    const int nblk = N / 32, kb = item / nblk, nb = item % nblk, k0 = 64 * kb, n0 = 32 * nb;
    int d0 = n0;
    if (mode == 1) { const int up = n0 >= FF ? 1 : 0, j = n0 - up * FF; d0 = 256 * (j >> 7) + 128 * up + (j & 127); }
    if (mode == 2 && n0 >= DM) { const int isv = n0 >= 2 * DM ? 1 : 0, j = n0 - DM - isv * DM; d0 = DM + 256 * (j >> 7) + 128 * isv + (j & 127); }
    { f32x4 t4[8]; const int nn = 4 * (lane & 7);
#pragma unroll
      for (int i = 0; i < 8; ++i) t4[i] = __builtin_nontemporal_load((const f32x4*)(W + (size_t)(k0 + 8 * i + (lane >> 3)) * N + n0 + nn));
#pragma unroll
      for (int i = 0; i < 8; ++i) { LAS float* d = scr + (8 * i + (lane >> 3)) * 33 + nn; d[0] = t4[i].x; d[1] = t4[i].y; d[2] = t4[i].z; d[3] = t4[i].w; } }
    LDS_WAIT(); asm volatile("" ::: "memory");
    const int c = lane & 7;
#pragma unroll
    for (int j = 0; j < 4; ++j) { const int n = (lane >> 3) + 8 * j; const LAS float* s = scr + (8 * c) * 33 + n;
        v4u o; o.x = pk2(s[0 * 33], s[1 * 33]); o.y = pk2(s[2 * 33], s[3 * 33]); o.z = pk2(s[4 * 33], s[5 * 33]); o.w = pk2(s[6 * 33], s[7 * 33]);
        __builtin_nontemporal_store(o, (v4u*)(WT + (size_t)(d0 + n) * K + k0 + 8 * c)); }
    LDS_WAIT(); asm volatile("" ::: "memory");
}

struct Ctx {
    LAS unsigned char* lds;
    int G, NGW, NT;
};
#define PHASE_IDS const int tid_ = opaque_tid(), lane_ = tid_ & 63, wave_ = __builtin_amdgcn_readfirstlane(tid_ >> 6), gw_ = (int)blockIdx.x * NWAVES + wave_, gt_ = (int)blockIdx.x * NTHREADS + tid_; (void)lane_; (void)gw_; (void)gt_

__device__ __forceinline__ void p0_weights(const Args& a, const Ctx& F) {
    PHASE_IDS;
    LAS float* scr = (LAS float*)(F.lds + wave_ * 16384);
    constexpr int I_FI = (DM / 64) * (NFF2 / 32), I_FO = (FF / 64) * (DM / 32), I_CI = (DM / 64) * (NCONV / 32), I_SQ = (DM / 64) * (DM / 32), I_QKV = (DM / 64) * (NQKV / 32);
    constexpr int NITEMS = 8 * I_FI + 8 * I_FO + 2 * I_CI + 2 * I_SQ + 2 * I_QKV + 2 * I_SQ;
    for (int it = gw_; it < NITEMS; it += F.NGW) {
        int r = it;
        if (r < 8 * I_FI) { const int m = r / I_FI; r -= m * I_FI; transpose_item(KARG(ffn_w_in) + (size_t)m * DM * NFF2, DM, NFF2, (bf16*)(KARG(ws) + WS_WFI) + (size_t)m * NFF2 * DM, 1, scr, r, lane_); continue; } r -= 8 * I_FI;
        if (r < 8 * I_FO) { const int m = r / I_FO; r -= m * I_FO; transpose_item(KARG(ffn_w_out) + (size_t)m * FF * DM, FF, DM, (bf16*)(KARG(ws) + WS_WFO) + (size_t)m * DM * FF, 0, scr, r, lane_); continue; } r -= 8 * I_FO;
        if (r < 2 * I_CI) { const int m = r / I_CI; r -= m * I_CI; transpose_item(KARG(conv_w_in) + (size_t)m * DM * NCONV, DM, NCONV, (bf16*)(KARG(ws) + WS_WCI) + (size_t)m * NCONV * DM, 2, scr, r, lane_); continue; } r -= 2 * I_CI;
        if (r < 2 * I_SQ) { const int m = r / I_SQ; r -= m * I_SQ; transpose_item(KARG(conv_w_out) + (size_t)m * DM * DM, DM, DM, (bf16*)(KARG(ws) + WS_WCO) + (size_t)m * DM * DM, 0, scr, r, lane_); continue; } r -= 2 * I_SQ;
        if (r < 2 * I_QKV) { const int m = r / I_QKV; r -= m * I_QKV; transpose_item(KARG(attn_w_qkv) + (size_t)m * DM * NQKV, DM, NQKV, (bf16*)(KARG(ws) + WS_WQKV) + (size_t)m * NQKV * DM, 0, scr, r, lane_); continue; } r -= 2 * I_QKV;
        { const int m = r / I_SQ; r -= m * I_SQ; transpose_item(KARG(attn_w_o) + (size_t)m * DM * DM, DM, DM, (bf16*)(KARG(ws) + WS_WO) + (size_t)m * DM * DM, 0, scr, r, lane_); }
    }
}

__device__ __forceinline__ void p0_ada_partial(const Args& a, const Ctx& F) {
    PHASE_IDS;
    __syncthreads();
    LAS float* s = (LAS float*)F.lds;
    for (int e = tid_; e < 9 * 1024; e += NTHREADS) { const int b = e >> 10, k = e & 1023; const float v = b < 8 ? KARG(c)[b * 1024 + k] : KARG(c_ctx)[k]; s[e] = v / (1.0f + __expf(-v)); }
    __syncthreads();
    float* part = (float*)(KARG(ws) + WS_PART);
    constexpr int NCG = MODW / 4, KC = 1024 / KSPLIT;
    for (int base_ = 0; base_ < NCG * KSPLIT; base_ += (F.NT >> 4) * 9) {
        const int it = base_ + (gt_ >> 4) * 9 + (gt_ & 15);
        if ((gt_ & 15) < 9 && it < NCG * KSPLIT) {
        const int cgp = it % NCG, kc = it / NCG, n = 4 * cgp, layer = n / NMOD, nn = n - layer * NMOD;
        const float* wp = KARG(ada_w) + ((size_t)layer * 1024 + kc * KC) * NMOD + nn;
        f32x4 acc[9];
#pragma unroll
        for (int b = 0; b < 9; ++b) acc[b] = (f32x4){0.f, 0.f, 0.f, 0.f};
        for (int k8 = 0; k8 < KC; k8 += 8) {
            f32x4 w[8];
#pragma unroll
            for (int q = 0; q < 8; ++q) w[q] = __builtin_nontemporal_load((const f32x4*)(wp + (size_t)(k8 + q) * NMOD));
#pragma unroll
            for (int b = 0; b < 9; ++b) { const f32x4 s0 = *(const LAS f32x4*)(s + b * 1024 + kc * KC + k8), s1 = *(const LAS f32x4*)(s + b * 1024 + kc * KC + k8 + 4);
                acc[b] = acc[b] + w[0] * s0.x + w[1] * s0.y + w[2] * s0.z + w[3] * s0.w + w[4] * s1.x + w[5] * s1.y + w[6] * s1.z + w[7] * s1.w; }
        }
#pragma unroll
        for (int b = 0; b < 9; ++b) *(f32x4*)(part + ((size_t)(kc * 9 + b)) * MODW + n) = acc[b];
        } }
    __syncthreads();
}
__device__ __forceinline__ void p0_rope_table(const Ctx& F) {
    PHASE_IDS;
    if (gt_ < 64 * 32) { const int pos = gt_ >> 5, f = gt_ & 31; const float inv = powf(10000.0f, -(float)f / 32.0f); const float ang = (float)pos * inv;
        float* t = (float*)(KARG(ws) + WS_ROPE); t[gt_] = cosf(ang); t[2048 + gt_] = sinf(ang); }
}
__device__ __forceinline__ void p1_ada_reduce(const Args& a, const Ctx& F) {
    PHASE_IDS;
    const float* part = (const float*)(KARG(ws) + WS_PART); float* mod = (float*)(KARG(ws) + WS_MOD);
    for (int e = gt_; e < 9 * MODW; e += F.NT) { const int b = e / MODW, n = e - b * MODW; float sacc = KARG(ada_b)[n];
#pragma unroll
        for (int kc = 0; kc < KSPLIT; ++kc) sacc += part[((size_t)(kc * 9 + b)) * MODW + n];
        mod[e] = sacc; }
}

template <int R> __device__ __forceinline__ void prep_rows(int row0, int stride, int lane_, const float* g, const float* modb, const float* x_in, const float* ctx_in, float* xres, bf16* xs, float* rss) {
    f32x4 v[R][4]; float ss[R]; int mi[R];
#pragma unroll
    for (int r = 0; r < R; ++r) { const int row = row0 + r * stride; const int b = row / TPB, t = row - b * TPB; const bool isctx = t < CTX; mi[r] = isctx ? 8 : b;
        const float* src = isctx ? ctx_in + (size_t)(b * CTX + t) * DM : x_in + (size_t)(b * SEQ + t - CTX) * DM;
#pragma unroll
        for (int j = 0; j < 4; ++j) v[r][j] = __builtin_nontemporal_load((const f32x4*)src + lane_ + 64 * j); }
#pragma unroll
    for (int r = 0; r < R; ++r) { float s_ = 0.f;
#pragma unroll
        for (int j = 0; j < 4; ++j) s_ += (v[r][j].x * v[r][j].x + v[r][j].y * v[r][j].y) + (v[r][j].z * v[r][j].z + v[r][j].w * v[r][j].w);
        ss[r] = s_; }
#pragma unroll
    for (int r = 0; r < R; ++r)
#pragma unroll
        for (int j = 0; j < 4; ++j) __builtin_nontemporal_store(v[r][j], (f32x4*)(xres + (size_t)(row0 + r * stride) * DM) + lane_ + 64 * j);
#pragma unroll
    for (int o = 1; o < 64; o <<= 1) {
#pragma unroll
        for (int r = 0; r < R; ++r) ss[r] += __shfl_xor(ss[r], o); }
#pragma unroll
    for (int r = 0; r < R; ++r) { const float* sc = modb + (size_t)mi[r] * MODW + 1024;
        if (lane_ == 0) rss[row0 + r * stride] = ss[r];
#pragma unroll
        for (int j = 0; j < 4; ++j) { const f32x4 gj = ((const f32x4*)g)[lane_ + 64 * j], sj = ((const f32x4*)sc)[lane_ + 64 * j];
            const f32x4 o = v[r][j] * gj * (sj + 1.0f);
            v2u w; w.x = pk2(o.x, o.y); w.y = pk2(o.z, o.w); ((v2u*)(xs + (size_t)(row0 + r * stride) * DM))[lane_ + 64 * j] = w; } }
}
__device__ __forceinline__ void prep_phase(const Args& a, const Ctx& F) {
    PHASE_IDS;
    const float* g = KARG(norm_g); const float* modb = (const float*)(KARG(ws) + WS_MOD);
    float* xres = (float*)(KARG(ws) + WS_XRES); bf16* xs = (bf16*)(KARG(ws) + WS_XN); float* rss = (float*)(KARG(ws) + WS_RSS); const float* x_in = KARG(x); const float* ctx_in = KARG(ctx);
    int row = gw_;
    for (; row + 3 * F.NGW < M; row += 4 * F.NGW) prep_rows<4>(row, F.NGW, lane_, g, modb, x_in, ctx_in, xres, xs, rss);
    for (; row < M; row += F.NGW) prep_rows<1>(row, F.NGW, lane_, g, modb, x_in, ctx_in, xres, xs, rss);
}
__device__ __forceinline__ int sl_cols(int sl) { const int layer = sl / 3, sub = sl - layer * 3; return sub != 1 ? NFF2 : ((layer & 1) ? NQKV : NCONV); }
__device__ __forceinline__ const bf16* sl_weights(unsigned char* ws, int sl) { const int layer = sl / 3, sub = sl - layer * 3;
    if (sub != 1) return (const bf16*)(ws + WS_WFI) + (size_t)(layer * 2 + (sub >> 1)) * NFF2 * DM;
    return (layer & 1) ? (const bf16*)(ws + WS_WQKV) + (size_t)(layer >> 1) * NQKV * DM : (const bf16*)(ws + WS_WCI) + (size_t)(layer >> 1) * NCONV * DM; }
__device__ __forceinline__ void bias_phase(const Args& a, const Ctx& F) {
    PHASE_IDS;
    unsigned char* ws = KARG(ws); const float* mod = (const float*)(ws + WS_MOD); float* sw = (float*)(ws + WS_SW);
    constexpr int NCOLS = 8 * NFF2 + 2 * NCONV + 2 * NQKV;
    const int per = (NCOLS + F.NGW - 1) / F.NGW; const int c0 = gw_ * per; const int c1 = (c0 + per < NCOLS) ? c0 + per : NCOLS;
    int sl = 0, base = 0, cur = -1; float shr[9][16];
#pragma unroll
    for (int mi = 0; mi < 9; ++mi)
#pragma unroll
        for (int k = 0; k < 16; ++k) shr[mi][k] = 0.f;
    for (int c = c0; c < c1; ++c) {
        while (c >= base + sl_cols(sl)) { base += sl_cols(sl); ++sl; }
        if (sl != cur) { cur = sl; const int layer = sl / 3, sub = sl - layer * 3; const float* sh = mod + layer * NMOD + (sub * 3) * 1024 + 16 * lane_;
#pragma unroll
            for (int mi = 0; mi < 9; ++mi)
#pragma unroll
                for (int q = 0; q < 4; ++q) { const f32x4 t4 = *(const f32x4*)(sh + (size_t)mi * MODW + 4 * q); shr[mi][4 * q] = t4.x; shr[mi][4 * q + 1] = t4.y; shr[mi][4 * q + 2] = t4.z; shr[mi][4 * q + 3] = t4.w; } }
        const int n = c - base; const bf16* wrow = sl_weights(ws, sl) + (size_t)n * DM + 16 * lane_;
        const v4u w0 = *(const v4u*)wrow, w1 = *(const v4u*)(wrow + 8);
        float wf[16];
#pragma unroll
        for (int q = 0; q < 4; ++q) { wf[2 * q] = bflo(w0[q]); wf[2 * q + 1] = bfhi(w0[q]); wf[8 + 2 * q] = bflo(w1[q]); wf[8 + 2 * q + 1] = bfhi(w1[q]); }
        float accb[9];
#pragma unroll
        for (int mi = 0; mi < 9; ++mi) { float t_ = 0.f;
#pragma unroll
            for (int k = 0; k < 16; ++k) t_ += wf[k] * shr[mi][k];
            accb[mi] = t_; }
#pragma unroll
        for (int o = 1; o < 64; o <<= 1) {
#pragma unroll
            for (int mi = 0; mi < 9; ++mi) accb[mi] += __shfl_xor(accb[mi], o); }
#pragma unroll
        for (int mi = 0; mi < 9; ++mi) if (lane_ == mi) sw[((size_t)sl * 9 + mi) * NFF2 + n] = accb[mi];
    }
}
template <int R> __device__ __forceinline__ void final_rows(int idx0, int stride, int lane_, const float* xres, const float* fg, float* out) {
    f32x4 v[R][4]; float ss[R];
#pragma unroll
    for (int r = 0; r < R; ++r) { const int idx = idx0 + r * stride, b = idx / SEQ, t = idx - b * SEQ; const float* src = xres + (size_t)(b * TPB + CTX + t) * DM;
#pragma unroll
        for (int j = 0; j < 4; ++j) v[r][j] = __builtin_nontemporal_load((const f32x4*)src + lane_ + 64 * j); }
#pragma unroll
    for (int r = 0; r < R; ++r) { float s_ = 0.f;
#pragma unroll
        for (int j = 0; j < 4; ++j) s_ += (v[r][j].x * v[r][j].x + v[r][j].y * v[r][j].y) + (v[r][j].z * v[r][j].z + v[r][j].w * v[r][j].w);
        ss[r] = s_; }
#pragma unroll
    for (int o = 1; o < 64; o <<= 1) {
#pragma unroll
        for (int r = 0; r < R; ++r) ss[r] += __shfl_xor(ss[r], o); }
#pragma unroll
    for (int r = 0; r < R; ++r) { const float rstd = 1.0f / sqrtf(ss[r] * (1.0f / DM) + EPS);
#pragma unroll
        for (int j = 0; j < 4; ++j) { const f32x4 gj = ((const f32x4*)fg)[lane_ + 64 * j]; __builtin_nontemporal_store(v[r][j] * rstd * gj, (f32x4*)(out + (size_t)(idx0 + r * stride) * DM) + lane_ + 64 * j); } }
}
__device__ __forceinline__ void final_phase(const Args& a, const Ctx& F) {
    PHASE_IDS;
    const float* xres = (const float*)(KARG(ws) + WS_XRES); const float* fg = KARG(final_g); float* out = KARG(out);
    int idx = gw_;
    for (; idx + 3 * F.NGW < NB * SEQ; idx += 4 * F.NGW) final_rows<4>(idx, F.NGW, lane_, xres, fg, out);
    for (; idx < NB * SEQ; idx += F.NGW) final_rows<1>(idx, F.NGW, lane_, xres, fg, out);
}

template <int R> __device__ __forceinline__ void conv_rows(int row0, int lane_, const bf16* bu, bf16* z, const float* cw) {
#pragma unroll
    for (int jj = 0; jj < 2; ++jj) { const int d = 8 * lane_ + 512 * jj;
        v4u ur[R + 2], br[R];
#pragma unroll
        for (int i = 0; i < R + 2; ++i) { const int rr = row0 - 1 + i; const bool ok = rr >= 0 && rr < M; ur[i] = *(const v4u*)(bu + (size_t)(ok ? rr : row0) * 2048 + DM + d); }
#pragma unroll
        for (int i = 0; i < R; ++i) br[i] = *(const v4u*)(bu + (size_t)(row0 + i) * 2048 + d);
        const f32x4 w0a = *(const f32x4*)(cw + d), w0b = *(const f32x4*)(cw + d + 4), w1a = *(const f32x4*)(cw + DM + d), w1b = *(const f32x4*)(cw + DM + d + 4), w2a = *(const f32x4*)(cw + 2 * DM + d), w2b = *(const f32x4*)(cw + 2 * DM + d + 4);
        const float w0[8] = {w0a.x, w0a.y, w0a.z, w0a.w, w0b.x, w0b.y, w0b.z, w0b.w}, w1[8] = {w1a.x, w1a.y, w1a.z, w1a.w, w1b.x, w1b.y, w1b.z, w1b.w}, w2[8] = {w2a.x, w2a.y, w2a.z, w2a.w, w2b.x, w2b.y, w2b.z, w2b.w};
#pragma unroll
        for (int i = 0; i < R; ++i) { const int row = row0 + i, b = row / TPB, t = row - b * TPB; const float mp = (t != 0 && t != CTX) ? 1.f : 0.f, mn = (t != CTX - 1 && t != TPB - 1) ? 1.f : 0.f;
            v4u o;
#pragma unroll
            for (int q = 0; q < 4; ++q) {
                const float ylo = mp * w0[2 * q] * bflo(ur[i][q]) + w1[2 * q] * bflo(ur[i + 1][q]) + mn * w2[2 * q] * bflo(ur[i + 2][q]);
                const float yhi = mp * w0[2 * q + 1] * bfhi(ur[i][q]) + w1[2 * q + 1] * bfhi(ur[i + 1][q]) + mn * w2[2 * q + 1] * bfhi(ur[i + 2][q]);
                o[q] = pk2(bflo(br[i][q]) * ylo, bfhi(br[i][q]) * yhi); }
            *(v4u*)(z + (size_t)row * DM + d) = o; } }
}
__device__ __forceinline__ void conv_phase(const Args& a, const Ctx& F, int j) {
    PHASE_IDS;
    const bf16* bcv = (const bf16*)(KARG(ws) + WS_BIG); bf16* z = (bf16*)(KARG(ws) + WS_XB); const float* cw = KARG(conv_w) + (size_t)j * 3 * DM;
    const int chunk = (M + F.NGW - 1) / F.NGW, r0 = gw_ * chunk, r1 = (r0 + chunk < M) ? r0 + chunk : M;
    int row = r0;
    for (; row + 2 <= r1; row += 2) conv_rows<2>(row, lane_, bcv, z, cw);
    for (; row < r1; ++row) conv_rows<1>(row, lane_, bcv, z, cw);
}

template <int R> __device__ __forceinline__ void normrope_rows(int row0, int stride, int lane, unsigned* qkv, const float* ct, const float* st, f32x2 gq, f32x2 gk) {
    const int axis = lane >> 5, half = (lane >> 4) & 1, f0 = 2 * (lane & 15);
    unsigned raw[R][10]; f32x2 cs[R], sn[R];
#pragma unroll
    for (int r = 0; r < R; ++r) { unsigned* base = qkv + (size_t)(row0 + r * stride) * (NQKV / 2);
#pragma unroll
        for (int h = 0; h < 10; ++h) raw[r][h] = base[h * 64 + lane]; }
#pragma unroll
    for (int r = 0; r < R; ++r) { const int row = row0 + r * stride, b = row / TPB, t = row - b * TPB; const bool isctx = t < CTX; const int tl = isctx ? 0 : t - CTX; const int pos = axis ? (tl & 63) : (tl >> 6);
        cs[r] = *(const f32x2*)(ct + pos * 32 + f0); sn[r] = *(const f32x2*)(st + pos * 32 + f0);
        if (isctx) { cs[r] = (f32x2){1.f, 1.f}; sn[r] = (f32x2){0.f, 0.f}; }
        if (half == 0) sn[r] = -sn[r]; }
#pragma unroll
    for (int r = 0; r < R; ++r) { unsigned* base = qkv + (size_t)(row0 + r * stride) * (NQKV / 2);
        float ssq[10];
#pragma unroll
        for (int h = 0; h < 10; ++h) { const float x0 = bflo(raw[r][h]), x1 = bfhi(raw[r][h]); ssq[h] = x0 * x0 + x1 * x1; }
#pragma unroll
        for (int o = 1; o < 64; o <<= 1) {
#pragma unroll
            for (int h = 0; h < 10; ++h) ssq[h] += __shfl_xor(ssq[h], o); }
#pragma unroll
        for (int h = 0; h < 10; ++h) { const float x0 = bflo(raw[r][h]), x1 = bfhi(raw[r][h]);
            const float rstd = 1.0f / sqrtf(ssq[h] * (1.0f / 128.0f) + EPS);
            const f32x2 gg = h < 8 ? gq : gk; const float y0 = x0 * rstd * gg.x, y1 = x1 * rstd * gg.y;
            const float p0 = __shfl_xor(y0, 16), p1 = __shfl_xor(y1, 16);
            const float qs = h < 8 ? 0.12751743f : 1.0f;
            base[h * 64 + lane] = pk2((y0 * cs[r].x + p0 * sn[r].x) * qs, (y1 * cs[r].y + p1 * sn[r].y) * qs); } }
}
__device__ __forceinline__ void normrope_phase(const Args& a, const Ctx& F, int j) {
    PHASE_IDS;
    unsigned* qkv = (unsigned*)(KARG(ws) + WS_BIG); const float* ct = (const float*)(KARG(ws) + WS_ROPE); const float* st = ct + 2048;
    const f32x2 gq = *(const f32x2*)(KARG(attn_q_g) + j * 128 + 2 * lane_), gk = *(const f32x2*)(KARG(attn_k_g) + j * 128 + 2 * lane_);
    int row = gw_;
    for (; row + 3 * F.NGW < M; row += 4 * F.NGW) normrope_rows<4>(row, F.NGW, lane_, qkv, ct, st, gq, gk);
    for (; row < M; row += F.NGW) normrope_rows<1>(row, F.NGW, lane_, qkv, ct, st, gq, gk);
}

__device__ __forceinline__ void attn_phase(const Args& a, const Ctx& F, char* shm, bool ctx_units, int jm) {
    const att::bf16* qkv = (const att::bf16*)(KARG(ws) + WS_BIG); att::bf16* O = (att::bf16*)(KARG(ws) + WS_XB);
    float mraw;
    { PHASE_IDS; const f32x2 gq = *(const f32x2*)(KARG(attn_q_g) + jm * 128 + 2 * lane_), gk = *(const f32x2*)(KARG(attn_k_g) + jm * 128 + 2 * lane_);
      float mq = fmaxf(fabsf(gq.x), fabsf(gq.y)), mk = fmaxf(fabsf(gk.x), fabsf(gk.y));
#pragma unroll
      for (int o_ = 1; o_ < 64; o_ <<= 1) { mq = fmaxf(mq, __shfl_xor(mq, o_)); mk = fmaxf(mk, __shfl_xor(mk, o_)); }
      mraw = 128.0f * mq * mk * 1.0005f; }
    const int c = blockIdx.x;
    for (int i = 0;; ++i) {
        int b, h, qb; bool cu = false;
        if (F.G == 256) {
            if (i < 4) { const int p = 2 * (c & 7) + (i >> 1), w = (i & 1) * 32 + (c >> 3); b = p >> 1; h = (p & 1) * 4 + (w >> 4); qb = w & 15; }
            else if (i == 4 && c < 64 && ctx_units) { cu = true; b = c >> 3; h = c & 7; qb = 0; }
            else break;
        } else {
            const int L = i * F.G + c;
            if (L < 1024) { b = L >> 7; h = (L >> 4) & 7; qb = L & 15; }
            else if (L < 1088 && ctx_units) { cu = true; b = (L - 1024) >> 3; h = L & 7; qb = 0; }
            else break;
        }
        const size_t rowb = (size_t)b * TPB, qrow = cu ? rowb : rowb + CTX + (size_t)qb * 256; const int kvh = h >> 2;
        __syncthreads();
        att::attn_dense_body<att::bf16>(qkv + qrow * NQKV + h * 128, qkv + rowb * NQKV + 1024 + kvh * 128, qkv + rowb * NQKV + 1280 + kvh * 128, O + qrow * DM + h * 128, cu ? CTX : TPB, shm, mraw);
    }
    __syncthreads();
}

__global__ void __launch_bounds__(NTHREADS, 2) fwd_megakernel(Args a) {
    extern __shared__ __attribute__((aligned(16))) unsigned char lds[];
    cg::grid_group grid = cg::this_grid();
    Ctx F;
    F.lds = (LAS unsigned char*)lds; F.G = gridDim.x; F.NGW = F.G * NWAVES; F.NT = F.G * NTHREADS;
#define mod ((const float*)(KARG(ws) + WS_MOD))
#define XN ((bf16*)(KARG(ws) + WS_XN))
#define BIG ((bf16*)(KARG(ws) + WS_BIG))
#define XRES ((float*)(KARG(ws) + WS_XRES))

    if (threadIdx.x < 64) ((LAS unsigned*)(lds + 131072))[threadIdx.x] = 0u;
    __syncthreads();
    (void)xcd_barrier_post((unsigned*)(KARG(ws) + WS_BAR), (volatile LAS unsigned*)(lds + 131072));
#define GSYNC() do { XcdBarrier b_; b_.bar = (unsigned*)(KARG(ws) + WS_BAR); b_.x = (unsigned)__builtin_amdgcn_readfirstlane((int)xb_xcc_id()); b_.st = (volatile LAS unsigned*)(lds + 131072); xcd_barrier(b_); } while (0)
    { PHASE_IDS; float* rss = (float*)(KARG(ws) + WS_RSS); for (int e = gt_; e < 12 * M / 4; e += F.NT) ((f32x4*)rss)[e] = (f32x4){0.f, 0.f, 0.f, 0.f}; }
    p0_weights(a, F);
    p0_ada_partial(a, F);
    p0_rope_table(F);
    grid.sync();
    p1_ada_reduce(a, F);
    GSYNC();
    prep_phase(a, F);
    bias_phase(a, F);
    GSYNC();

    for (int layer = 0; layer < 4; ++layer) {
        const bool is_attn = (layer & 1) != 0; const int jm = layer >> 1;
        for (int sub = 0; sub < 3; ++sub) {
            const int sl = layer * 3 + sub;
            const float* rss = (const float*)(KARG(ws) + WS_RSS) + (size_t)sl * M; const float* sw = (const float*)(KARG(ws) + WS_SW) + (size_t)sl * 9 * NFF2;
            const float* gate = mod + layer * NMOD + (sub * 3 + 2) * 1024;
            const bf16* A2; const bf16* B2; int K2; float coef;
            if (sub != 1) {
                const int fi = layer * 2 + (sub >> 1);
                { pg8::Gemm g{XN, (const bf16*)(KARG(ws) + WS_WFI) + (size_t)fi * NFF2 * DM, M, NFF2, DM}; pg8::StaticOrder S; S.init(M, NFF2, DM, F.G, (int)blockIdx.x, (layer == 3 && sub == 2) ? 1 : 0);
                  pg8::EpiSwiglu E{BIG, FF, rss, sw};
                  pg8::gemm_phase<pg8::EpiSwiglu, pg8::StaticOrder, true, true>(F.lds, g, S, E); }
                GSYNC();
                A2 = BIG; B2 = (const bf16*)(KARG(ws) + WS_WFO) + (size_t)fi * DM * FF; K2 = FF; coef = 0.5f;
            } else {
                const int N1 = is_attn ? NQKV : NCONV;
                { pg8::Gemm g{XN, is_attn ? (const bf16*)(KARG(ws) + WS_WQKV) + (size_t)jm * NQKV * DM : (const bf16*)(KARG(ws) + WS_WCI) + (size_t)jm * NCONV * DM, M, N1, DM};
                  pg8::TailOrder S; S.init(M, N1, DM, F.G, (int)blockIdx.x);
                  if (is_attn) { pg8::EpiBf16N E{BIG, N1, rss, sw}; pg8::gemm_phase<pg8::EpiBf16N, pg8::TailOrder, true, true>(F.lds, g, S, E); }
                  else { pg8::EpiConvIn E{BIG, rss, sw}; pg8::gemm_phase<pg8::EpiConvIn, pg8::TailOrder, true, true>(F.lds, g, S, E); } }
                GSYNC();
                if (is_attn) { normrope_phase(a, F, jm); GSYNC(); attn_phase(a, F, (char*)lds, layer != 3, jm); }
                else conv_phase(a, F, jm);
                GSYNC();
                A2 = (const bf16*)(KARG(ws) + WS_XB); B2 = is_attn ? (const bf16*)(KARG(ws) + WS_WO) + (size_t)jm * DM * DM : (const bf16*)(KARG(ws) + WS_WCO) + (size_t)jm * DM * DM; K2 = DM; coef = 1.0f;
            }
            { pg8::Gemm g{A2, B2, M, DM, K2}; pg8::TailOrder S; S.init(M, DM, K2, F.G, (int)blockIdx.x, (layer == 3 && sub >= 1) ? 1 : 0);
              const int sn = sl + 1, ln = sn / 3, subn = sn - ln * 3; const bool fold = sn < 12;
              unsigned char* wsp = KARG(ws); const int snc = fold ? sn : 0, lnc = fold ? ln : 0;
              float* e_x = (float*)(wsp + WS_XRES); bf16* e_xs = fold ? (bf16*)(wsp + WS_XN) : (bf16*)nullptr; const float* e_gn = KARG(norm_g) + (size_t)snc * 1024;
              const float* e_scn = (const float*)(wsp + WS_MOD) + lnc * NMOD + (subn * 3 + 1) * 1024; float* e_rssn = (float*)(wsp + WS_RSS) + (size_t)snc * M;
              const pg8::EpiRes E{e_x, gate, sub != 1 ? 1 : 0, e_xs, e_gn, e_scn, e_rssn};
              pg8::gemm_phase<pg8::EpiRes, pg8::TailOrder, true, true>(F.lds, g, S, E); }
            GSYNC();
        }
    }
    final_phase(a, F);
}

extern "C" void kernel_launch(void* const* d_in, const int* in_sizes, int n_in, void* d_out, int out_size, void* d_ws, size_t ws_size, hipStream_t stream) {
    static int grid = 0;
    if (grid == 0) {
        if (n_in != 17 || in_sizes[0] != NB * SEQ * DM || out_size != NB * SEQ * DM || ws_size < WS_END) {
            fprintf(stderr, "kernel_launch: shape/workspace mismatch: n_in %d in0 %d out %d ws %zu (need %zu)\n", n_in, n_in > 0 ? in_sizes[0] : -1, out_size, ws_size, (size_t)WS_END); grid = -1; return; }
        int dev = 0, cus = 0, per_cu = 0;
        if (hipGetDevice(&dev) != hipSuccess || hipDeviceGetAttribute(&cus, hipDeviceAttributeMultiprocessorCount, dev) != hipSuccess) { fprintf(stderr, "kernel_launch: device query failed\n"); grid = -1; return; }
        if (hipFuncSetAttribute((const void*)fwd_megakernel, hipFuncAttributeMaxDynamicSharedMemorySize, LDS_BYTES) != hipSuccess) { fprintf(stderr, "kernel_launch: hipFuncSetAttribute failed\n"); grid = -1; return; }
        if (hipOccupancyMaxActiveBlocksPerMultiprocessor(&per_cu, (const void*)fwd_megakernel, NTHREADS, LDS_BYTES) != hipSuccess || per_cu < 1) { fprintf(stderr, "kernel_launch: occupancy query gave %d\n", per_cu); (void)hipGetLastError(); per_cu = 1; }
        grid = cus * per_cu;
    }
    if (grid < 0) return;
    if (hipMemsetAsync((char*)d_ws + WS_BAR, 0, BAR_BYTES, stream) != hipSuccess) { fprintf(stderr, "kernel_launch: hipMemsetAsync failed\n"); return; }
    Args a{};
    a.x = (const float*)d_in[0]; a.c = (const float*)d_in[1]; a.ctx = (const float*)d_in[2]; a.c_ctx = (const float*)d_in[3]; a.ada_w = (const float*)d_in[4]; a.ada_b = (const float*)d_in[5];
    a.norm_g = (const float*)d_in[6]; a.final_g = (const float*)d_in[7]; a.ffn_w_in = (const float*)d_in[8]; a.ffn_w_out = (const float*)d_in[9]; a.conv_w_in = (const float*)d_in[10]; a.conv_w = (const float*)d_in[11];
    a.conv_w_out = (const float*)d_in[12]; a.attn_w_qkv = (const float*)d_in[13]; a.attn_q_g = (const float*)d_in[14]; a.attn_k_g = (const float*)d_in[15]; a.attn_w_o = (const float*)d_in[16];
    a.out = (float*)d_out; a.ws = (unsigned char*)d_ws;
    void* args[] = {&a};
    const hipError_t e = hipLaunchCooperativeKernel((const void*)fwd_megakernel, dim3(grid), dim3(NTHREADS), args, LDS_BYTES, stream);
    if (e != hipSuccess) fprintf(stderr, "kernel_launch: cooperative launch failed: %s (grid %d)\n", hipGetErrorString(e), grid);
}
```
